# Optimizing an MI355X kernel written in HIP

```python
import math
import jax, jax.numpy as jnp
from jax import lax
import numpy as np

D_MODEL = 1024
BATCH = 8
SEQ = 4096
DEPTH = 2

LRU_WIDTH = D_MODEL // 4
LRU_BLOCKS = 4
LRU_BLOCK_W = LRU_WIDTH // LRU_BLOCKS
LRU_CONV = 4
LRU_C = 8.0
GLA_HEADS = 4
GLA_DV = (D_MODEL // 4) // GLA_HEADS
GLA_DK = GLA_DV // 2
GLA_GATE_RANK = 16
GLA_TAU = 16.0
GLA_CHUNK = 64
MOBA_HEADS = 8
MOBA_DH = (D_MODEL // 2) // MOBA_HEADS
MOBA_BLOCK = 256
MOBA_TOPK = 3
MOBA_Q_CHUNK = 128
REL_BUCKETS = 32
REL_MAX_DIST = 128
D_FF = -(-8 * D_MODEL // (3 * 256)) * 256

GLA_QK_W = GLA_HEADS * GLA_DK
GLA_V_W = GLA_HEADS * GLA_DV
MOBA_W = MOBA_HEADS * MOBA_DH
D_MIX = LRU_WIDTH + GLA_V_W + MOBA_W
IN_SPLITS = (LRU_WIDTH, LRU_WIDTH, GLA_QK_W, GLA_QK_W, GLA_V_W, GLA_GATE_RANK, GLA_V_W, MOBA_W, MOBA_W, MOBA_W)
D_IN = sum(IN_SPLITS)
RMS_EPS = 1e-6
NEG_INF = -1e30

kernel_name = "hymba_rglru_gla_moba_sandwich"


def rms_norm(x, g):
    xf = x.astype(jnp.float32)
    y = xf * lax.rsqrt(jnp.mean(xf * xf, axis=-1, keepdims=True) + RMS_EPS)
    return (y * g.astype(jnp.float32)).astype(x.dtype)


def split_heads(t, n):
    b, s, w = t.shape
    return t.astype(jnp.float32).reshape(b, s, n, w // n).transpose(0, 2, 1, 3)


def t5_bucket(rel):
    n = jnp.maximum(rel, 0)
    max_exact = REL_BUCKETS // 2
    nf = jnp.maximum(n, 1).astype(jnp.float32)
    large = max_exact + (jnp.log(nf / max_exact) / math.log(REL_MAX_DIST / max_exact)
                         * (REL_BUCKETS - max_exact)).astype(jnp.int32)
    large = jnp.minimum(large, REL_BUCKETS - 1)
    return jnp.where(n < max_exact, n, large)


def rg_lru_branch(xb, gb, conv_w, conv_b, wa, ba, wx, bx, lam):
    b, s, c = xb.shape
    xc = lax.conv_general_dilated(xb, conv_w[:, None, :].astype(xb.dtype), window_strides=(1,),
                                  padding=[(LRU_CONV - 1, 0)],
                                  dimension_numbers=('NWC', 'WIO', 'NWC'),
                                  feature_group_count=c)
    xc = xc.astype(jnp.float32) + conv_b.astype(jnp.float32)
    xg = xc.reshape(b, s, LRU_BLOCKS, LRU_BLOCK_W)
    r = jax.nn.sigmoid(jnp.einsum('bsgi,gij->bsgj', xg, wa.astype(jnp.float32)).reshape(b, s, c)
                       + ba.astype(jnp.float32))
    i = jax.nn.sigmoid(jnp.einsum('bsgi,gij->bsgj', xg, wx.astype(jnp.float32)).reshape(b, s, c)
                       + bx.astype(jnp.float32))
    log_a = -LRU_C * r * jax.nn.softplus(-lam.astype(jnp.float32))
    a = jnp.exp(log_a)
    mult = jnp.sqrt(-jnp.expm1(2.0 * log_a))
    mult = mult.at[:, 0].set(1.0)
    u = mult * (i * xc)

    def combine(left, right):
        a1, b1 = left
        a2, b2 = right
        return a1 * a2, a2 * b1 + b2

    _, h = lax.associative_scan(combine, (a, u), axis=1)
    return h * jax.nn.gelu(gb.astype(jnp.float32))


def gla_chunked(q, k, v, g):
    b, h, s, dk = q.shape
    dv = v.shape[-1]
    c = GLA_CHUNK
    n = s // c
    q = q.reshape(b, h, n, c, dk) * (dk ** -0.5)
    k = k.reshape(b, h, n, c, dk)
    v = v.reshape(b, h, n, c, dv)
    cum = jnp.cumsum(g.reshape(b, h, n, c, dk), axis=3)
    last = cum[:, :, :, -1:, :]
    q_d = q * jnp.exp(cum)
    k_d = k * jnp.exp(-cum)
    causal = jnp.tril(jnp.ones((c, c), dtype=bool))
    attn = jnp.where(causal, jnp.einsum('bhncd,bhned->bhnce', q_d, k_d), 0.0)
    intra = jnp.einsum('bhnce,bhnev->bhncv', attn, v)
    kv = jnp.einsum('bhncd,bhncv->bhndv', k * jnp.exp(last - cum), v)
    decay = jnp.exp(last[:, :, :, 0, :])

    def step(state, inp):
        kv_n, d_n = inp
        return d_n[..., None] * state + kv_n, state

    init = jnp.zeros((b, h, dk, dv), jnp.float32)
    _, s_prev = lax.scan(step, init, (kv.transpose(2, 0, 1, 3, 4), decay.transpose(2, 0, 1, 3)))
    s_prev = s_prev.transpose(1, 2, 0, 3, 4)
    inter = jnp.einsum('bhncd,bhndv->bhncv', q_d, s_prev)
    return (intra + inter).reshape(b, h, s, dv)


def moba_attention(q, k, v, rel_bias):
    b, h, s, d = q.shape
    nb = -(-s // MOBA_BLOCK)
    pad = nb * MOBA_BLOCK - s
    k_blk = jnp.pad(k, ((0, 0), (0, 0), (0, pad), (0, 0))).reshape(b, h, nb, MOBA_BLOCK, d)
    v_blk = jnp.pad(v, ((0, 0), (0, 0), (0, pad), (0, 0))).reshape(b, h, nb, MOBA_BLOCK, d)
    k_mean = jnp.mean(k_blk, axis=3)
    topk = min(MOBA_TOPK, nb)
    scale = d ** -0.5
    bias_h = rel_bias.T.astype(jnp.float32)
    bi = jnp.arange(b)[:, None, None]
    hi = jnp.arange(h)[None, :, None]
    blk_ids = jnp.arange(nb)
    offs = jnp.arange(MOBA_BLOCK)

    def chunk(ci):
        q0 = ci * MOBA_Q_CHUNK
        qc = lax.dynamic_slice_in_dim(q, q0, MOBA_Q_CHUNK, axis=2)
        qpos = q0 + jnp.arange(MOBA_Q_CHUNK)
        n_past = q0 // MOBA_BLOCK
        gate = jnp.einsum('bhqd,bhnd->bhqn', qc, k_mean)
        gate = jnp.where(blk_ids < n_past, gate, -jnp.inf)
        _, sel = lax.top_k(gate, topk)
        k_own = lax.dynamic_index_in_dim(k_blk, n_past, axis=2, keepdims=False)
        v_own = lax.dynamic_index_in_dim(v_blk, n_past, axis=2, keepdims=False)
        rel_own = qpos[:, None] - (n_past * MOBA_BLOCK + offs)[None, :]
        logit_own = (jnp.einsum('bhqd,bhkd->bhqk', qc, k_own) * scale
                     + bias_h[:, t5_bucket(rel_own)])
        logit_own = jnp.where(rel_own >= 0, logit_own, NEG_INF)
        logits = []
        for j in range(topk):
            idx = sel[..., j]
            kj = k_blk[bi, hi, idx]
            rel = qpos[:, None] - (idx[..., None] * MOBA_BLOCK + offs)
            bias = bias_h[hi[..., None], t5_bucket(rel)]
            lj = jnp.einsum('bhqd,bhqkd->bhqk', qc, kj) * scale + bias
            logits.append(jnp.where(j < n_past, lj, NEG_INF))
        logits.append(logit_own)
        p = jax.nn.softmax(jnp.concatenate(logits, axis=-1), axis=-1)
        p = p.reshape(b, h, MOBA_Q_CHUNK, topk + 1, MOBA_BLOCK)
        out = jnp.einsum('bhqk,bhkd->bhqd', p[..., topk, :], v_own)
        for j in range(topk):
            vj = v_blk[bi, hi, sel[..., j]]
            out = out + jnp.einsum('bhqk,bhqkd->bhqd', p[..., j, :], vj)
        return out

    out = lax.map(chunk, jnp.arange(s // MOBA_Q_CHUNK))
    return out.transpose(1, 2, 0, 3, 4).reshape(b, h, s, d)


def hybrid_mixer(h, w_in, conv_w, conv_b, wa, ba, wx, bx, lam, gate_w2, gate_b, gla_gain, rel_bias):
    bsz, s, _ = h.shape
    proj = h @ w_in
    split_points = [int(p) for p in np.cumsum(IN_SPLITS)[:-1]]
    lru_x, lru_g, gq, gk, gv, g_lr, g_out, mq, mk, mv = jnp.split(proj, split_points, axis=-1)
    y_lru = rg_lru_branch(lru_x, lru_g, conv_w, conv_b, wa, ba, wx, bx, lam)
    log_alpha = jax.nn.log_sigmoid((g_lr @ gate_w2 + gate_b).astype(jnp.float32)) / GLA_TAU
    o = gla_chunked(split_heads(gq, GLA_HEADS), split_heads(gk, GLA_HEADS),
                    split_heads(gv, GLA_HEADS), split_heads(log_alpha, GLA_HEADS))
    o = o.transpose(0, 2, 1, 3)
    o = o * lax.rsqrt(jnp.mean(o * o, axis=-1, keepdims=True) + RMS_EPS)
    y_gla = (o.reshape(bsz, s, GLA_V_W) * gla_gain.astype(jnp.float32)
             * jax.nn.silu(g_out.astype(jnp.float32)))
    y_moba = moba_attention(split_heads(mq, MOBA_HEADS), split_heads(mk, MOBA_HEADS),
                            split_heads(mv, MOBA_HEADS), rel_bias)
    y_moba = y_moba.transpose(0, 2, 1, 3).reshape(bsz, s, MOBA_W)
    return jnp.concatenate([y_lru, y_gla, y_moba], axis=-1).astype(h.dtype)


def setup_inputs(seed: int = 0) -> dict:
    key = jax.random.key(seed)
    ks = jax.random.split(key, 24)
    f32 = jnp.float32
    L = DEPTH

    def nrm(k, shape, scale):
        return jax.random.normal(k, shape, f32) * scale

    u = jax.random.uniform(ks[12], (L, LRU_WIDTH), f32, 0.9, 0.999) ** (1.0 / LRU_C)
    return {
        'x': nrm(ks[0], (BATCH, SEQ, D_MODEL), 1.0),
        'pre_mix_norm': 1.0 + nrm(ks[1], (L, D_MODEL), 0.02),
        'post_mix_norm': 1.0 + nrm(ks[2], (L, D_MODEL), 0.02),
        'pre_ffn_norm': 1.0 + nrm(ks[3], (L, D_MODEL), 0.02),
        'post_ffn_norm': 1.0 + nrm(ks[4], (L, D_MODEL), 0.02),
        'w_in': nrm(ks[5], (L, D_MODEL, D_IN), D_MODEL ** -0.5),
        'w_out': nrm(ks[6], (L, D_MIX, D_MODEL), D_MIX ** -0.5),
        'lru_conv_w': nrm(ks[7], (L, LRU_CONV, LRU_WIDTH), LRU_CONV ** -0.5),
        'lru_conv_b': nrm(ks[8], (L, LRU_WIDTH), 0.01),
        'lru_wa': nrm(ks[9], (L, LRU_BLOCKS, LRU_BLOCK_W, LRU_BLOCK_W), LRU_BLOCK_W ** -0.5),
        'lru_ba': nrm(ks[10], (L, LRU_WIDTH), 0.01),
        'lru_wx': nrm(ks[11], (L, LRU_BLOCKS, LRU_BLOCK_W, LRU_BLOCK_W), LRU_BLOCK_W ** -0.5),
        'lru_bx': nrm(ks[13], (L, LRU_WIDTH), 0.01),
        'lru_lambda': jnp.log(u) - jnp.log1p(-u),
        'gla_gate_w2': nrm(ks[14], (L, GLA_GATE_RANK, GLA_QK_W), GLA_GATE_RANK ** -0.5),
        'gla_gate_b': nrm(ks[15], (L, GLA_QK_W), 0.01),
        'gla_norm': 1.0 + nrm(ks[16], (L, GLA_V_W), 0.02),
        'rel_bias': nrm(ks[17], (REL_BUCKETS, MOBA_HEADS), 0.2),
        'w_ffn_gate': nrm(ks[18], (L, D_MODEL, D_FF), D_MODEL ** -0.5),
        'w_ffn_up': nrm(ks[19], (L, D_MODEL, D_FF), D_MODEL ** -0.5),
        'w_ffn_down': nrm(ks[20], (L, D_FF, D_MODEL), D_FF ** -0.5),
    }


def reference(x, pre_mix_norm, post_mix_norm, pre_ffn_norm, post_ffn_norm, w_in, w_out,
              lru_conv_w, lru_conv_b, lru_wa, lru_ba, lru_wx, lru_bx, lru_lambda,
              gla_gate_w2, gla_gate_b, gla_norm, rel_bias, w_ffn_gate, w_ffn_up, w_ffn_down):
    for l in range(DEPTH):
        h = rms_norm(x, pre_mix_norm[l])
        mix = hybrid_mixer(h, w_in[l], lru_conv_w[l], lru_conv_b[l], lru_wa[l], lru_ba[l],
                           lru_wx[l], lru_bx[l], lru_lambda[l], gla_gate_w2[l], gla_gate_b[l],
                           gla_norm[l], rel_bias)
        x = x + rms_norm(mix @ w_out[l], post_mix_norm[l])
        h = rms_norm(x, pre_ffn_norm[l])
        f = (jax.nn.silu(h @ w_ffn_gate[l]) * (h @ w_ffn_up[l])) @ w_ffn_down[l]
        x = x + rms_norm(f, post_ffn_norm[l])
    return x
```

```cpp
#include <hip/hip_runtime.h>
#include <cstdio>
#include <cstdint>
namespace pg8 {
#define PG8_LAS __attribute__((address_space(3)))
typedef unsigned short bf16_t;
typedef short bf16x8 __attribute__((ext_vector_type(8)));
typedef float f32x4 __attribute__((ext_vector_type(4)));
typedef unsigned u32x4 __attribute__((ext_vector_type(4)));
constexpr int BM = 256, BK = 64, HALF = 128, HTB = HALF * BK * 2  , STAGE_BYTES = 8 * HTB, NXCD = 8, WGM = 8;

__host__ __device__ __forceinline__ int lds_byte(int r, int c) { const int st = (r >> 4) * 2 + (c >> 5), rr = r & 15, cc = c & 31, ob = rr * 64 + cc * 2; return st * 1024 + (ob ^ (((ob >> 9) & 1) << 5)); }
__host__ __device__ __forceinline__ void stage_rc(int b, int& R, int& C) { const int st = b / 1024, sb = b % 1024, swz = sb ^ (((sb >> 9) & 1) << 5); R = (st >> 1) * 16 + swz / 64; C = (st & 1) * 32 + (swz % 64) / 2; }
__host__ __device__ __forceinline__ int perm32(int rho) { const int n = rho >> 4, i = rho & 15; return 8 * (i >> 2) + 4 * n + (i & 3); }

struct Unit { int pm, pn; };
struct Gemm { const bf16_t* A; const bf16_t* Bt; int M, N, K; };

struct StaticOrder {
    int nM, nN, nwg, G, c;
    __host__ __device__ void init(int M, int N, int G_, int c_) { nM = M / BM; nN = N / BM; nwg = nM * nN; G = G_; c = c_; }
    __host__ __device__ bool next(int i, Unit& u) const {
        const long L = (long)i * G + c; if (L >= nwg) return false;
        int wgid = (int)L; { const int q = nwg / NXCD, r = nwg % NXCD, xcd = wgid % NXCD, off = wgid / NXCD; wgid = (xcd < r ? xcd * (q + 1) : r * (q + 1) + (xcd - r) * q) + off; }
        const int nig = WGM * nN, gid = wgid / nig, fm = gid * WGM, gsz = (nM - fm) < WGM ? (nM - fm) : WGM;
        u.pm = fm + ((wgid % nig) % gsz); u.pn = (wgid % nig) / gsz; return true;
    }
    __device__ __forceinline__ void a_ready(const Unit&) const {}
    __device__ __forceinline__ void done(const Unit&) const {}
};

__device__ __forceinline__ unsigned cvt_pk_bf16(float lo, float hi) { unsigned r; asm volatile("v_cvt_pk_bf16_f32 %0, %1, %2" : "=v"(r) : "v"(lo), "v"(hi)); return r; }
typedef float f32x2 __attribute__((ext_vector_type(2)));
struct EpiF32 {
    static constexpr bool PERM = false, AFTER_DRAIN = false;
    float* C; int ldc; const float* bias;
    __device__ __forceinline__ void operator()(const f32x4 (&acc)[2][2][4][2], const Unit& u, int wr, int wc, int fr, int fq) const {
        const int row0 = u.pm * BM + wr * 64 + fr, col0 = u.pn * BM + wc * 32 + 4 * fq;
        f32x4 bv[2][2];
#pragma unroll
        for (int bj = 0; bj < 2; ++bj)
#pragma unroll
            for (int n = 0; n < 2; ++n) bv[bj][n] = bias ? *(const f32x4*)(bias + col0 + bj * HALF + n * 16) : (f32x4){0.f, 0.f, 0.f, 0.f};
#pragma unroll
        for (int ai = 0; ai < 2; ++ai)
#pragma unroll
            for (int m = 0; m < 4; ++m) { float* rowp = C + (size_t)(row0 + ai * HALF + m * 16) * ldc + col0;
#pragma unroll
                for (int bj = 0; bj < 2; ++bj)
#pragma unroll
                    for (int n = 0; n < 2; ++n) *(f32x4*)(rowp + bj * HALF + n * 16) = acc[ai][bj][m][n] + bv[bj][n]; }
    }
};
template <int ACT  > struct EpiBf16 {
    static constexpr bool PERM = true, AFTER_DRAIN = false; static_assert(ACT == 0 || ACT == 1, "EpiBf16: ACT is 0 (none) or 1 (gelu_pk)");
    bf16_t* O; int ldc; const float* bias; int split_cols; size_t split_stride; float scale0;
    __device__ __forceinline__ void operator()(const f32x4 (&acc)[2][2][4][2], const Unit& u, int wr, int wc, int fr, int fq) const {
        const int row0 = u.pm * BM + wr * 64 + fr; int colt = u.pn * BM; bf16_t* base = O;
        float sc = 1.f; if (split_cols) { const int t = colt / split_cols; base += (size_t)t * split_stride; colt -= t * split_cols; if (t == 0) sc = scale0; }
        const int col0 = colt + wc * 32 + 8 * fq, bcol0 = u.pn * BM + wc * 32 + 8 * fq;
        f32x4 bv[2][2];
#pragma unroll
        for (int bj = 0; bj < 2; ++bj)
#pragma unroll
            for (int n = 0; n < 2; ++n) bv[bj][n] = bias ? *(const f32x4*)(bias + bcol0 + bj * HALF + 4 * n) : (f32x4){0.f, 0.f, 0.f, 0.f};
#pragma unroll
        for (int ai = 0; ai < 2; ++ai)
#pragma unroll
            for (int m = 0; m < 4; ++m) { bf16_t* rowp = base + (size_t)(row0 + ai * HALF + m * 16) * ldc + col0;
#pragma unroll
                for (int bj = 0; bj < 2; ++bj) { f32x4 v0 = acc[ai][bj][m][0] + bv[bj][0], v1 = acc[ai][bj][m][1] + bv[bj][1];
                    v0 = v0 * sc; v1 = v1 * sc; u32x4 w; w.x = cvt_pk_bf16(v0[0], v0[1]); w.y = cvt_pk_bf16(v0[2], v0[3]); w.z = cvt_pk_bf16(v1[0], v1[1]); w.w = cvt_pk_bf16(v1[2], v1[3]);
                    *(u32x4*)(rowp + bj * HALF) = w; } }
    }
};
struct EpiSwiGLU {
    static constexpr bool PERM = true, AFTER_DRAIN = false;
    bf16_t* O; int ldc;
    __device__ __forceinline__ void operator()(const f32x4 (&acc)[2][2][4][2], const Unit& u, int wr, int wc, int fr, int fq) const {
        const int row0 = u.pm * BM + wr * 64 + fr, col0 = u.pn * HALF + wc * 32 + 8 * fq;
#pragma unroll
        for (int ai = 0; ai < 2; ++ai)
#pragma unroll
            for (int m = 0; m < 4; ++m) { bf16_t* rowp = O + (size_t)(row0 + ai * HALF + m * 16) * ldc + col0;
                float hv[8];
#pragma unroll
                for (int n = 0; n < 2; ++n)
#pragma unroll
                    for (int i = 0; i < 4; ++i) { const float g = acc[ai][0][m][n][i], up = acc[ai][1][m][n][i];
                        const float e = __builtin_amdgcn_exp2f(g * -1.4426950408889634f); hv[n * 4 + i] = g * __builtin_amdgcn_rcpf(1.0f + e) * up; }
                u32x4 w; w.x = cvt_pk_bf16(hv[0], hv[1]); w.y = cvt_pk_bf16(hv[2], hv[3]); w.z = cvt_pk_bf16(hv[4], hv[5]); w.w = cvt_pk_bf16(hv[6], hv[7]);
                *(u32x4*)rowp = w; }
    }
};
template <class Epi, class Sched, bool ALIGN_EPI = false, bool SP2 = false>
__device__ __forceinline__ void gemm_phase(PG8_LAS unsigned char* lds, const Gemm g, const Sched& S, const Epi& E) {
    const int tid = threadIdx.x, wid = __builtin_amdgcn_readfirstlane(tid >> 6), lane = tid & 63, wr = wid >> 2, wc = wid & 3, fr = lane & 15, fq = lane >> 4;
    const int K = g.K, nt = K / BK;
    unsigned voffA[2], voffB[2];
#pragma unroll
    for (int i = 0; i < 2; ++i) { int R, C; stage_rc(tid * 16 + i * 8192, R, C); const int Rb = Epi::PERM ? ((R & ~31) + perm32(R & 31)) : R;
        voffA[i] = (unsigned)(R * K + C) * 2u; voffB[i] = (unsigned)(Rb * K + C) * 2u; }
    const size_t kstep = (size_t)(BK * 2);
    const size_t hstep = (size_t)HALF * K * 2;
    const size_t tstep = 2 * hstep;
    const unsigned ldsw = (unsigned)wid * 1024u;
    const int aoff = lds_byte(wr * 64 + fr, fq * 8), boff = lds_byte(wc * 32 + fr, fq * 8);
#define PG8_SA(b, h) (((b) * 2 + (h)) * HTB)
#define PG8_SB(b, h) ((4 + (b) * 2 + (h)) * HTB)
#define PG8_STAGE(bufoff, gbase, voff) do { _Pragma("unroll") for (int _i = 0; _i < 2; ++_i) \
        __builtin_amdgcn_global_load_lds((const unsigned*)((const char*)(gbase) + (voff)[_i]), (PG8_LAS unsigned*)(lds + (bufoff) + ldsw + _i * 8192), 16, 0, 0); } while (0)
#define PG8_LDA(dst, b, h) do { _Pragma("unroll") for (int m = 0; m < 4; ++m) _Pragma("unroll") for (int k = 0; k < 2; ++k) dst[m][k] = *(const PG8_LAS bf16x8*)(lds + PG8_SA(b, h) + aoff + m * 2048 + k * 1024); } while (0)
#define PG8_LDB(dst, b, h) do { _Pragma("unroll") for (int n = 0; n < 2; ++n) _Pragma("unroll") for (int k = 0; k < 2; ++k) dst[n][k] = *(const PG8_LAS bf16x8*)(lds + PG8_SB(b, h) + boff + n * 2048 + k * 1024); } while (0)
#define PG8_MMA(ai, bj, At, Bt) do { __builtin_amdgcn_s_setprio(1); _Pragma("unroll") for (int m = 0; m < 4; ++m) _Pragma("unroll") for (int n = 0; n < 2; ++n) _Pragma("unroll") for (int k = 0; k < 2; ++k) \
        acc[ai][bj][m][n] = __builtin_amdgcn_mfma_f32_16x16x32_bf16(Bt[n][k], At[m][k], acc[ai][bj][m][n], 0, 0, 0); __builtin_amdgcn_s_setprio(0); } while (0)
#define PG8_WAIT_V(n) asm volatile("s_waitcnt vmcnt(" #n ")" ::: "memory")
#define PG8_WAIT_L(n) asm volatile("s_waitcnt lgkmcnt(" #n ")" ::: "memory")
#define PG8_BAR __builtin_amdgcn_s_barrier()
#define PG8_SCHED __builtin_amdgcn_sched_barrier(0)
    Unit cur, nxt; int ui = 0;
    if (!S.next(0, cur)) return;
    f32x4 acc[2][2][4][2];
#pragma unroll
    for (int a = 0; a < 2; ++a)
#pragma unroll
        for (int b = 0; b < 2; ++b)
#pragma unroll
            for (int m = 0; m < 4; ++m)
#pragma unroll
                for (int n = 0; n < 2; ++n) acc[a][b][m][n] = (f32x4){0.f, 0.f, 0.f, 0.f};
    bf16x8 At[4][2], B0[2][2], B1[2][2];
    const char* cA = (const char*)g.A + (size_t)cur.pm * tstep; const char* cB = (const char*)g.Bt + (size_t)cur.pn * tstep;
    S.a_ready(cur);
    if constexpr (SP2) {
        PG8_STAGE(PG8_SB(0, 0), cB, voffB); PG8_STAGE(PG8_SB(0, 1), cB + hstep, voffB); PG8_STAGE(PG8_SA(0, 0), cA, voffA); PG8_STAGE(PG8_SA(0, 1), cA + hstep, voffA);
        if (wr == 1) PG8_BAR;
        PG8_WAIT_V(2); PG8_BAR;
        PG8_STAGE(PG8_SB(1, 0), cB + kstep, voffB); PG8_STAGE(PG8_SA(1, 0), cA + kstep, voffA); PG8_STAGE(PG8_SB(1, 1), cB + hstep + kstep, voffB);
        PG8_WAIT_V(6); PG8_BAR;
    } else {
        PG8_STAGE(PG8_SB(0, 0), cB, voffB); PG8_STAGE(PG8_SA(0, 0), cA, voffA); PG8_STAGE(PG8_SB(0, 1), cB + hstep, voffB); PG8_STAGE(PG8_SA(0, 1), cA + hstep, voffA);
        if (wr == 1) PG8_BAR;
        PG8_WAIT_V(4); PG8_BAR;
        PG8_STAGE(PG8_SB(1, 0), cB + kstep, voffB); PG8_STAGE(PG8_SA(1, 0), cA + kstep, voffA); PG8_STAGE(PG8_SB(1, 1), cB + hstep + kstep, voffB);
        PG8_WAIT_V(6); PG8_BAR;
    }
    for (;;) {
        const bool has_next = S.next(ui + 1, nxt);
        const char* nA = has_next ? (const char*)g.A + (size_t)nxt.pm * tstep : cA; const char* nB = has_next ? (const char*)g.Bt + (size_t)nxt.pn * tstep : cB;
        for (int t = 0; t < nt; t += 2) {
            const bool last = (t == nt - 2);
            const char* a1 = cA + (size_t)(t + 1) * kstep;
            const char* a2 = last ? nA : cA + (size_t)(t + 2) * kstep; const char* b2 = last ? nB : cB + (size_t)(t + 2) * kstep;
            const char* a3 = a2 + kstep; const char* b3 = b2 + kstep;
            if (last && has_next) S.a_ready(nxt);
            if constexpr (SP2) {
            PG8_LDB(B0, 0, 0); PG8_LDB(B1, 0, 1); PG8_SCHED; PG8_LDA(At, 0, 0); PG8_STAGE(PG8_SA(1, 1), a1 + hstep, voffA);
            PG8_WAIT_V(8); PG8_WAIT_L(0); PG8_BAR; PG8_MMA(0, 0, At, B0); PG8_MMA(0, 1, At, B1); PG8_BAR; PG8_SCHED;
            PG8_LDA(At, 0, 1); PG8_STAGE(PG8_SB(0, 0), b2, voffB); PG8_STAGE(PG8_SB(0, 1), b2 + hstep, voffB); PG8_STAGE(PG8_SA(0, 0), a2, voffA);
            PG8_WAIT_V(8); PG8_WAIT_L(0); PG8_BAR; PG8_MMA(1, 0, At, B0); PG8_MMA(1, 1, At, B1); PG8_BAR; PG8_SCHED;
            PG8_LDB(B0, 1, 0); PG8_LDB(B1, 1, 1); PG8_SCHED; PG8_LDA(At, 1, 0); PG8_STAGE(PG8_SA(0, 1), a2 + hstep, voffA);
            PG8_WAIT_V(8); PG8_WAIT_L(0); PG8_BAR; PG8_MMA(0, 0, At, B0); PG8_MMA(0, 1, At, B1); PG8_BAR; PG8_SCHED;
            PG8_LDA(At, 1, 1); PG8_STAGE(PG8_SB(1, 0), b3, voffB); PG8_STAGE(PG8_SB(1, 1), b3 + hstep, voffB); PG8_STAGE(PG8_SA(1, 0), a3, voffA);
            PG8_WAIT_V(8); PG8_WAIT_L(0); PG8_BAR; PG8_MMA(1, 0, At, B0); PG8_MMA(1, 1, At, B1); PG8_BAR; PG8_SCHED;
            } else {
            PG8_LDB(B0, 0, 0); PG8_SCHED; PG8_LDA(At, 0, 0); PG8_STAGE(PG8_SA(1, 1), a1 + hstep, voffA);
            PG8_WAIT_L(8); PG8_BAR; PG8_WAIT_L(0); PG8_MMA(0, 0, At, B0); PG8_BAR; PG8_SCHED;
            PG8_LDB(B1, 0, 1); PG8_STAGE(PG8_SB(0, 0), b2, voffB);
            PG8_BAR; PG8_WAIT_L(0); PG8_MMA(0, 1, At, B1); PG8_BAR;
            PG8_LDA(At, 0, 1); PG8_STAGE(PG8_SA(0, 0), a2, voffA);
            PG8_BAR; PG8_WAIT_L(0); PG8_MMA(1, 0, At, B0); PG8_BAR; PG8_SCHED;
            PG8_STAGE(PG8_SB(0, 1), b2 + hstep, voffB);
            PG8_WAIT_V(6); PG8_BAR; PG8_MMA(1, 1, At, B1); PG8_BAR;
            PG8_LDB(B0, 1, 0); PG8_SCHED; PG8_LDA(At, 1, 0); PG8_STAGE(PG8_SA(0, 1), a2 + hstep, voffA);
            PG8_WAIT_L(8); PG8_BAR; PG8_WAIT_L(0); PG8_MMA(0, 0, At, B0); PG8_BAR; PG8_SCHED;
            PG8_LDB(B1, 1, 1); PG8_STAGE(PG8_SB(1, 0), b3, voffB);
            PG8_BAR; PG8_WAIT_L(0); PG8_MMA(0, 1, At, B1); PG8_BAR;
            PG8_LDA(At, 1, 1); PG8_STAGE(PG8_SA(1, 0), a3, voffA);
            PG8_BAR; PG8_WAIT_L(0); PG8_MMA(1, 0, At, B0); PG8_BAR; PG8_SCHED;
            PG8_STAGE(PG8_SB(1, 1), b3 + hstep, voffB);
            PG8_WAIT_V(6); PG8_BAR; PG8_MMA(1, 1, At, B1); PG8_BAR;
            }
        }
        if constexpr (ALIGN_EPI) { if (wr == 0) PG8_BAR; }
        if constexpr (!Epi::AFTER_DRAIN) { E(acc, cur, wr, wc, fr, fq); S.done(cur); }
        if (!has_next) break;
#pragma unroll
        for (int a = 0; a < 2; ++a)
#pragma unroll
            for (int b = 0; b < 2; ++b)
#pragma unroll
                for (int m = 0; m < 4; ++m)
#pragma unroll
                    for (int n = 0; n < 2; ++n) acc[a][b][m][n] = (f32x4){0.f, 0.f, 0.f, 0.f};
        cur = nxt; cA = nA; cB = nB; ++ui;
        if constexpr (ALIGN_EPI) { if (wr == 1) PG8_BAR; }
    }
    PG8_WAIT_V(0);
    if constexpr (!ALIGN_EPI) { if (wr == 0) PG8_BAR; }
    PG8_BAR;
    if constexpr (Epi::AFTER_DRAIN) { E.fused(acc, cur, wr, wc, fr, fq, lds, wid, lane); S.done(cur); }
#undef PG8_SA
#undef PG8_SB
#undef PG8_STAGE
#undef PG8_LDA
#undef PG8_LDB
#undef PG8_MMA
#undef PG8_WAIT_V
#undef PG8_WAIT_L
#undef PG8_BAR
#undef PG8_SCHED
}
}

#ifndef EXP_MASK
#define EXP_MASK 15
#endif
#ifndef FAST_FLAGS
#define FAST_FLAGS 15
#endif
constexpr int NWAVES = 8, NTHR = 512;
constexpr int BATCH = 8, SEQ = 4096, DM = 1024, M = BATCH * SEQ, NLAYER = 2;
constexpr int D_IN = 2832, LDP = 3072, DFF = 2816, NGU = 2 * DFF;
constexpr int C_LX = 0, C_LG = 256, C_GQ = 512, C_GK = 640, C_GV = 768, C_GO = 1024, C_MQ = 1280, C_MK = 1792, C_MV = 2304, C_GZ = 2816;
constexpr float RMS_EPS = 1e-6f;
constexpr float LOG2E = 1.4426950408889634f;
constexpr float MOBA_C2 = 0.125f * LOG2E;
constexpr float GLA_QS = 0.17677669529663687f;

constexpr size_t MiB = 1u << 20;
constexpr size_t WS_CTL = 0, CTL_ZERO_BYTES = 1 * MiB;
constexpr size_t WS_W = 2 * MiB, W_LAYER = 25 * MiB;
constexpr size_t WO_IN = 0, WO_OUT = 6 * MiB, WO_GU = 8 * MiB, WO_D = 19 * MiB;
constexpr size_t WS_MISC = 52 * MiB;
constexpr size_t WS_KMEAN = WS_MISC, WS_BIAS = WS_MISC + 1 * MiB, WS_LRUW = WS_BIAS + 65536  , WS_LRUSUM = WS_MISC + 2 * MiB, WS_GLASUM = WS_MISC + 3 * MiB;
constexpr size_t WS_XN = 64 * MiB, WS_PROJ = 128 * MiB, WS_MIX = 320 * MiB, WS_Y = 384 * MiB, WS_END = 512 * MiB;
constexpr int CW_TMO = 0, CW_CODE = 1, CW_BAR = 4096;

constexpr int RING_BYTES = 131072, LDSCTL_OFF = RING_BYTES, MISC_OFF = LDSCTL_OFF + 320, LDS_BYTES = 147456;

#define GAS __attribute__((address_space(1)))
#define LAS __attribute__((address_space(3)))
typedef unsigned short bf16;
typedef unsigned v4u __attribute__((ext_vector_type(4)));
typedef float f32x4 __attribute__((ext_vector_type(4)));
typedef GAS unsigned gu32;
#define RLX_AGENT __ATOMIC_RELAXED, __HIP_MEMORY_SCOPE_AGENT
#define LDS_WAIT() asm volatile("s_waitcnt lgkmcnt(0)" ::: "memory")
__device__ __forceinline__ unsigned f2bf(float f) { unsigned u = __builtin_bit_cast(unsigned, f); return (u + 0x7fffu + ((u >> 16) & 1u)) >> 16; }
__device__ __forceinline__ unsigned pk2(float lo, float hi) { return f2bf(lo) | (f2bf(hi) << 16); }
__device__ __forceinline__ float bf2f(unsigned v) { return __builtin_bit_cast(float, v << 16); }
__device__ __forceinline__ float bflo(unsigned w) { return __builtin_bit_cast(float, w << 16); }
__device__ __forceinline__ float bfhi(unsigned w) { return __builtin_bit_cast(float, w & 0xffff0000u); }

#define XB_TMO      128
#define XB_XCNT(j)  (256  + 64 * (j))
#define XB_XSUB(j)  (1280 + 64 * (j))
#define XB_XGEN(j)  (2304 + 64 * (j))
#define XB_TOP      3328
#define XB_TOPGEN   3392
#define XCD_BAR_WORDS 3456
#define XB_SPIN_CAP (1u << 18)

__device__ __forceinline__ unsigned xb_ld(unsigned* p)              { return __hip_atomic_load(p, __ATOMIC_RELAXED, __HIP_MEMORY_SCOPE_AGENT); }
__device__ __forceinline__ unsigned xb_add(unsigned* p, unsigned v) { return __hip_atomic_fetch_add(p, v, __ATOMIC_RELAXED, __HIP_MEMORY_SCOPE_AGENT); }
__device__ __forceinline__ unsigned xb_xcc_id() { return (unsigned)__builtin_amdgcn_s_getreg((3 << 11) | 20) & 0xFu; }
#define XB_SPIN(cond, bar) do { unsigned _sp = 0; while (cond) { __builtin_amdgcn_s_sleep(1); \
    if ((++_sp & 255u) == 0u) { if (xb_ld(&(bar)[XB_TMO])) break; if (_sp > XB_SPIN_CAP) { atomicAdd(&(bar)[XB_TMO], 1u); break; } } } } while (0)

struct XcdBarrier {
    unsigned* bar; unsigned x;
    volatile LAS unsigned* st;
};

__device__ __forceinline__ XcdBarrier xcd_barrier_post(unsigned* bar, volatile LAS unsigned* st) {
    XcdBarrier b; b.bar = bar; b.x = xb_xcc_id(); b.st = st;
    if (threadIdx.x == 0) (void)xb_add(&bar[XB_XCNT(b.x)], 1u);
    return b;
}
__device__ __forceinline__ void xcd_barrier_complete(unsigned* bar, unsigned x, unsigned& nloc, unsigned& nx) {
    const unsigned G = gridDim.x * gridDim.y * gridDim.z;
    unsigned sum, cnt, mine, sp = 0u;
    for (;;) {
        sum = 0u; cnt = 0u; mine = 0u;
#pragma unroll
        for (unsigned j = 0; j < 16; ++j) { const unsigned c = xb_ld(&bar[XB_XCNT(j)]); sum += c; cnt += (c > 0u) ? 1u : 0u; mine = (j == x) ? c : mine; }
        if (sum == G) break;
        __builtin_amdgcn_s_sleep(1);
        if ((++sp & 255u) == 0u) { if (xb_ld(&bar[XB_TMO])) break; if (sp > XB_SPIN_CAP) { atomicAdd(&bar[XB_TMO], 1u); break; } }
    }
    nloc = mine > 0u ? mine : 1u; nx = cnt > 0u ? cnt : 1u;
}

__device__ __forceinline__ void xcd_barrier(const XcdBarrier& b) {
    asm volatile("s_waitcnt vmcnt(0)" ::: "memory");
    __syncthreads();
    if (threadIdx.x == 0) {
        unsigned* bar = b.bar;
        __builtin_amdgcn_s_waitcnt(0);
        unsigned nloc = b.st[0], nx = b.st[1];
        if (nloc == 0u) { xcd_barrier_complete(bar, b.x, nloc, nx); b.st[0] = nloc; b.st[1] = nx; }
        const unsigned old = xb_add(&bar[XB_XSUB(b.x)], 1u);
        const unsigned gen = old / nloc;
        if (old + 1u == (gen + 1u) * nloc) {
            __builtin_amdgcn_fence(__ATOMIC_RELEASE, "agent");
            asm volatile("s_waitcnt vmcnt(0)" ::: "memory");
            const unsigned og = xb_add(&bar[XB_TOP], 1u);
            const unsigned tg = og / nx;
            if (og + 1u == (tg + 1u) * nx) xb_add(&bar[XB_TOPGEN], 1u);
            else XB_SPIN(xb_ld(&bar[XB_TOPGEN]) == tg, bar);
            __builtin_amdgcn_fence(__ATOMIC_ACQUIRE, "agent");
            xb_add(&bar[XB_XGEN(b.x)], 1u);
            asm volatile("s_waitcnt vmcnt(0)" ::: "memory");
        } else {
            XB_SPIN(xb_ld(&bar[XB_XGEN(b.x)]) == gen, bar);
            __builtin_amdgcn_fence(__ATOMIC_ACQUIRE, "agent");
            asm volatile("s_waitcnt vmcnt(0)" ::: "memory");
        }
    }
    __syncthreads();
}

__device__ __forceinline__ float wave_sum(float v) {
#pragma unroll
    for (int o = 1; o < 64; o <<= 1) v += __shfl_xor(v, o);
    return v;
}
__device__ __forceinline__ float sigmoidf_(float x) { return 1.0f / (1.0f + __expf(-x)); }
__device__ __forceinline__ float softplusf_(float x) { return fmaxf(x, 0.f) + log1pf(__expf(-fabsf(x))); }
__device__ __forceinline__ float gelu_tanh(float x) { const float u = 0.7978845608028654f * (x + 0.044715f * x * x * x); return 0.5f * x * (1.0f + tanhf(u)); }
__device__ __forceinline__ int t5_bucket(int n) {
    if (n < 16) return n;
    int v = 16;
    v += (n >= 19) + (n >= 21) + (n >= 24) + (n >= 27) + (n >= 31) + (n >= 35) + (n >= 40) + (n >= 46) + (n >= 52) + (n >= 59) + (n >= 67) + (n >= 77) + (n >= 87) + (n >= 99) + (n >= 113);
    return v;
}

__device__ __forceinline__ void tr_item(const float* W, int ldw, int s0, int K, bf16* WT, int n0, int k0, float scale, LAS float* scr, int lane) {
#pragma unroll 8
    for (int i = 0; i < 32; ++i) { const int kk = 2 * i + (lane >> 5); scr[kk * 33 + (lane & 31)] = W[(size_t)(k0 + kk) * ldw + s0 + (lane & 31)] * scale; }
    LDS_WAIT(); asm volatile("" ::: "memory");
    const int c = lane & 7;
#pragma unroll
    for (int j = 0; j < 4; ++j) { const int n = (lane >> 3) + 8 * j; const LAS float* s = scr + (8 * c) * 33 + n;
        v4u o; o.x = pk2(s[0 * 33], s[1 * 33]); o.y = pk2(s[2 * 33], s[3 * 33]); o.z = pk2(s[4 * 33], s[5 * 33]); o.w = pk2(s[6 * 33], s[7 * 33]);
        *(GAS v4u*)(WT + (size_t)(n0 + n) * K + k0 + 8 * c) = o; }
    LDS_WAIT(); asm volatile("" ::: "memory");
}
__device__ __forceinline__ void trz_item(const float* W, const float* w2, bf16* WT, int n0, int j0, int k0, LAS float* scr, int lane) {
    const int n = lane & 31;
    float w2c[16];
#pragma unroll
    for (int r = 0; r < 16; ++r) w2c[r] = w2[r * 128 + j0 + n];
#pragma unroll 4
    for (int i = 0; i < 32; ++i) { const int kk = 2 * i + (lane >> 5); const float* wr = W + (size_t)(k0 + kk) * D_IN + 1024; float s = 0.f;
#pragma unroll
        for (int r = 0; r < 16; ++r) s += wr[r] * w2c[r];
        scr[kk * 33 + n] = s; }
    LDS_WAIT(); asm volatile("" ::: "memory");
    const int c = lane & 7;
#pragma unroll
    for (int j = 0; j < 4; ++j) { const int nn = (lane >> 3) + 8 * j; const LAS float* s = scr + (8 * c) * 33 + nn;
        v4u o; o.x = pk2(s[0 * 33], s[1 * 33]); o.y = pk2(s[2 * 33], s[3 * 33]); o.z = pk2(s[4 * 33], s[5 * 33]); o.w = pk2(s[6 * 33], s[7 * 33]);
        *(GAS v4u*)(WT + (size_t)(n0 + nn) * DM + k0 + 8 * c) = o; }
    LDS_WAIT(); asm volatile("" ::: "memory");
}

struct Args { const float* in[21]; float* out; unsigned char* ws; int ph_lo, ph_hi, flags, pad; };

__device__ __forceinline__ void norm_row(const float* xrow, const float* g, bf16* orow, int lane) {
    const GAS f32x4* xr = (const GAS f32x4*)xrow + lane; const GAS f32x4* gr = (const GAS f32x4*)g + lane;
    f32x4 v[4]; float s = 0.f;
#pragma unroll
    for (int j = 0; j < 4; ++j) { v[j] = xr[64 * j]; s += (v[j].x * v[j].x + v[j].y * v[j].y) + (v[j].z * v[j].z + v[j].w * v[j].w); }
    const float rstd = 1.0f / sqrtf(wave_sum(s) * (1.f / DM) + RMS_EPS);
    GAS unsigned long long* o8 = (GAS unsigned long long*)orow + lane;
#pragma unroll
    for (int j = 0; j < 4; ++j) { const f32x4 gg = gr[64 * j];
        o8[64 * j] = (unsigned long long)pk2(v[j].x * rstd * gg.x, v[j].y * rstd * gg.y) | ((unsigned long long)pk2(v[j].z * rstd * gg.z, v[j].w * rstd * gg.w) << 32); }
}
__device__ __forceinline__ void resnorm_row(const float* yrow, const float* xirow, const float* gpost, float* xorow, const float* gnext, bf16* xnrow, int lane) {
    const GAS f32x4* yr = (const GAS f32x4*)yrow + lane; const GAS f32x4* xr = (const GAS f32x4*)xirow + lane; const GAS f32x4* gp = (const GAS f32x4*)gpost + lane;
    f32x4 v[4]; float s = 0.f;
#pragma unroll
    for (int j = 0; j < 4; ++j) { v[j] = yr[64 * j]; s += (v[j].x * v[j].x + v[j].y * v[j].y) + (v[j].z * v[j].z + v[j].w * v[j].w); }
    const float rstd = 1.0f / sqrtf(wave_sum(s) * (1.f / DM) + RMS_EPS);
    float s2 = 0.f;
#pragma unroll
    for (int j = 0; j < 4; ++j) { const f32x4 xx = xr[64 * j], gg = gp[64 * j]; v[j] = xx + v[j] * rstd * gg; s2 += (v[j].x * v[j].x + v[j].y * v[j].y) + (v[j].z * v[j].z + v[j].w * v[j].w); }
    GAS f32x4* xo = (GAS f32x4*)xorow + lane;
#pragma unroll
    for (int j = 0; j < 4; ++j) xo[64 * j] = v[j];
    if (gnext) {
        const float rstd2 = 1.0f / sqrtf(wave_sum(s2) * (1.f / DM) + RMS_EPS);
        const GAS f32x4* gr = (const GAS f32x4*)gnext + lane; GAS unsigned long long* o8 = (GAS unsigned long long*)xnrow + lane;
#pragma unroll
        for (int j = 0; j < 4; ++j) { const f32x4 gg = gr[64 * j];
            o8[64 * j] = (unsigned long long)pk2(v[j].x * rstd2 * gg.x, v[j].y * rstd2 * gg.y) | ((unsigned long long)pk2(v[j].z * rstd2 * gg.z, v[j].w * rstd2 * gg.w) << 32); }
    }
}


#include <hip/hip_bf16.h>
#include <cmath>
namespace attn_body {
using bf16=__hip_bfloat16;
using bf16x8=__attribute__((ext_vector_type(8)))short;
using s16x4=__attribute__((ext_vector_type(4)))short;
using f32x16=__attribute__((ext_vector_type(16)))float;
using u32x4=__attribute__((ext_vector_type(4)))unsigned;
constexpr int BATCH=8,NHEAD=8,SEQ=4096,D=64,PQ=3072,PO=1024;
constexpr int NW=8,QBLK=32,QB=QBLK*NW,KVBLK=64,NQB=SEQ/QB;
constexpr int ATTN_UNIT_ROWS=QB;
__device__ __forceinline__ int crow(int r,int hi){return (r&3)+8*(r>>2)+4*hi;}
#define SBAR() __builtin_amdgcn_sched_barrier(0)
__device__ __forceinline__ void cmask(f32x16&p0,f32x16&p1,int jb,int qrel,int hi){
  const float NEG=-INFINITY; int kb=64*jb+4*hi;
  #pragma unroll
  for(int r=0;r<16;++r){int kv=kb+(r&3)+8*(r>>2); if(kv>qrel)p0[r]=NEG; if(kv+32>qrel)p1[r]=NEG;}
}

constexpr int NSLOT=3, SLOTB=8192;
constexpr int LDS_K=0, LDS_V=NSLOT*SLOTB, LDS_WS=2*NSLOT*SLOTB, LDS_OST=LDS_WS+NW*64*4, LDS_BYTES=LDS_OST+NW*4096, LDS_KM=LDS_BYTES, LDS_BT=LDS_KM+4096, LDS_TOTAL=LDS_BT+1024;
constexpr float C2=0.125f*1.4426950408889634f;
__device__ __forceinline__ void glds16(const void*gsrc,unsigned lds_dst){unsigned keep;
  asm volatile("s_mov_b32 %0, m0\n\ts_mov_b32 m0, %2\n\ts_nop 0\n\tglobal_load_lds_dwordx4 %1, off\n\ts_mov_b32 m0, %0":"=&s"(keep):"v"(gsrc),"s"(lds_dst):"memory");}
__device__ __forceinline__ float max3f(float a,float b,float c){float r;asm("v_max3_f32 %0, %1, %2, %3":"=v"(r):"v"(a),"v"(b),"v"(c));return r;}
__device__ __forceinline__ float max2f(float a,float b){float r;asm("v_max_f32_e32 %0, %1, %2":"=v"(r):"v"(a),"v"(b));return r;}
__device__ __forceinline__ float fadd_s(float a,float b){float r;asm("v_add_f32_e32 %0, %1, %2":"=v"(r):"v"(a),"v"(b));return r;}
__device__ __forceinline__ float fsub_s(float a,float b){float r;asm("v_sub_f32_e32 %0, %1, %2":"=v"(r):"v"(a),"v"(b));return r;}
typedef float f32x2_t __attribute__((ext_vector_type(2))); typedef __bf16 bf16x2_t __attribute__((ext_vector_type(2)));
__device__ __forceinline__ unsigned cvtpk_s(float lo,float hi){f32x2_t v={lo,hi};bf16x2_t b=__builtin_convertvector(v,bf16x2_t);return __builtin_bit_cast(unsigned,b);}
#define WAIT_BAR(N) asm volatile("s_waitcnt vmcnt(" #N ") lgkmcnt(0)\n\ts_barrier":::"memory")

__device__ __forceinline__ void qkt(f32x16&p0,f32x16&p1,const char*Kslot,const bf16x8*qr,const f32x16&negm,int r32,int hi){
  const char*kb=Kslot+hi*1024+r32*16;
  #pragma unroll
  for(int d0=0;d0<4;++d0){
    const bf16x8 b0=*reinterpret_cast<const bf16x8*>(kb+d0*2048);
    const bf16x8 b1=*reinterpret_cast<const bf16x8*>(kb+d0*2048+512);
    if(d0==0){p0=__builtin_amdgcn_mfma_f32_32x32x16_bf16(b0,qr[0],negm,0,0,0);p1=__builtin_amdgcn_mfma_f32_32x32x16_bf16(b1,qr[0],negm,0,0,0);}
    else{p0=__builtin_amdgcn_mfma_f32_32x32x16_bf16(b0,qr[d0],p0,0,0,0);p1=__builtin_amdgcn_mfma_f32_32x32x16_bf16(b1,qr[d0],p1,0,0,0);}}
}
typedef __attribute__((address_space(3))) const char* lds_cptr;
typedef short v4i16_t __attribute__((ext_vector_type(4)));
__device__ __forceinline__ void kload8(bf16x8*kf,lds_cptr kp){
  kf[0]=*(const __attribute__((address_space(3))) bf16x8*)(kp);      kf[1]=*(const __attribute__((address_space(3))) bf16x8*)(kp+512);
  kf[2]=*(const __attribute__((address_space(3))) bf16x8*)(kp+2048); kf[3]=*(const __attribute__((address_space(3))) bf16x8*)(kp+2560);
  kf[4]=*(const __attribute__((address_space(3))) bf16x8*)(kp+4096); kf[5]=*(const __attribute__((address_space(3))) bf16x8*)(kp+4608);
  kf[6]=*(const __attribute__((address_space(3))) bf16x8*)(kp+6144); kf[7]=*(const __attribute__((address_space(3))) bf16x8*)(kp+6656);
}
__device__ __forceinline__ void kload2(bf16x8*kf,lds_cptr kp,int j){ kf[2*j]=*(const __attribute__((address_space(3))) bf16x8*)(kp+j*2048); kf[2*j+1]=*(const __attribute__((address_space(3))) bf16x8*)(kp+j*2048+512); }
__device__ __forceinline__ s16x4 vtr(lds_cptr p){ return __builtin_bit_cast(s16x4,__builtin_amdgcn_ds_read_tr16_b64_v4i16((__attribute__((address_space(3))) v4i16_t*)p)); }
__device__ __forceinline__ float rowmax(const f32x16&p0,const f32x16&p1){
  float a=max3f(p0[0],p0[1],p1[0]),b=max3f(p0[2],p0[3],p1[1]);a=max3f(a,p1[2],p1[3]);
  #pragma unroll
  for(int r=4;r<16;r+=4){a=max3f(a,p0[r],p0[r+1]);b=max3f(b,p0[r+2],p0[r+3]);a=max3f(a,p1[r],p1[r+1]);b=max3f(b,p1[r+2],p1[r+3]);}
  const float m=max2f(a,b);
  auto rr=__builtin_amdgcn_permlane32_swap(__float_as_uint(m),__float_as_uint(m),false,false);
  return max2f(__uint_as_float(rr[0]),__uint_as_float(rr[1]));
}
__device__ __forceinline__ void pv(f32x16*o,int vb,bf16x8 pa0,bf16x8 pa1,bf16x8 pa2,bf16x8 pa3){
  #pragma unroll
  for(int d0=0;d0<2;++d0){s16x4 lo[4],hi[4];
    #pragma unroll
    for(int ks=0;ks<4;++ks){
      asm volatile("ds_read_b64_tr_b16 %0,%1 offset:%c2":"=&v"(lo[ks]):"v"(vb),"i"(d0*4096+ks*1024):"memory");
      asm volatile("ds_read_b64_tr_b16 %0,%1 offset:%c2":"=&v"(hi[ks]):"v"(vb),"i"(d0*4096+ks*1024+512):"memory");}
    asm volatile("s_waitcnt lgkmcnt(0)":::"memory");SBAR();
    #define PK(k) (bf16x8){lo[k][0],lo[k][1],lo[k][2],lo[k][3],hi[k][0],hi[k][1],hi[k][2],hi[k][3]}
    o[d0]=__builtin_amdgcn_mfma_f32_32x32x16_bf16(pa0,PK(0),o[d0],0,0,0);
    o[d0]=__builtin_amdgcn_mfma_f32_32x32x16_bf16(pa1,PK(1),o[d0],0,0,0);
    o[d0]=__builtin_amdgcn_mfma_f32_32x32x16_bf16(pa2,PK(2),o[d0],0,0,0);
    o[d0]=__builtin_amdgcn_mfma_f32_32x32x16_bf16(pa3,PK(3),o[d0],0,0,0);
    #undef PK
  }
}

typedef __attribute__((address_space(3))) const float* lds_cfptr;
__device__ __forceinline__ void cbias(f32x16&p0,f32x16&p1,lds_cfptr bt,int dbase){
  #pragma unroll
  for(int g=0;g<4;++g){
    #pragma unroll
    for(int e=0;e<4;++e){ const int r=4*g+e; const int d0=dbase-((r&3)+8*(r>>2)); const int d1=d0-32;
      p0[r]+=bt[min(max(d0,0),128)]; p1[r]+=bt[min(max(d1,0),128)]; }
    asm volatile("":::"memory"); }
}
#ifndef ATTN_STORE16
#define ATTN_STORE16(p,v) (*(u32x4*)(p)=(v))
#endif
template<int THRL> __device__ __forceinline__ void attn_unit(int b,int h,int qb,const bf16*Q,const bf16*__restrict__ K,const bf16*__restrict__ V,bf16*O,const float*kmean_bh,const float*biast_h,char*shm){
  const int tid=threadIdx.x,lane=tid&63,r32=lane&31,hi=lane>>5; const int wid=__builtin_amdgcn_readfirstlane(tid>>6);
  const long rowbase=(long)b*SEQ; const int q0=qb*QB;
  const bf16*Qw=Q+(rowbase+q0+wid*QBLK)*PQ+h*D;
  const bf16*Kh=K+rowbase*PQ+h*D,*Vh=V+rowbase*PQ+h*D;
  const unsigned lds0=(unsigned)(uintptr_t)shm;
  float*wsf=(float*)(shm+LDS_WS)+wid*64;
  const bf16*ksrc=Kh+(long)lane*PQ+wid*8;
  const bf16*vsrc=Vh+(long)(16*(wid&3)+(lane>>2))*PQ+(wid>>2)*32+(lane&3)*8;
  const unsigned kdst=lds0+LDS_K+wid*1024, vdst=lds0+LDS_V+wid*1024;
  #define DMA_K(t,slot) glds16(ksrc+(long)(t)*KVBLK*PQ,(unsigned)__builtin_amdgcn_readfirstlane(kdst+(slot)))
  #define DMA_V(t,slot) glds16(vsrc+(long)(t)*KVBLK*PQ,(unsigned)__builtin_amdgcn_readfirstlane(vdst+(slot)))
  const int vb0=(int)(lds0+LDS_V)+((lane>>4)&1)*32+(lane&3)*8+(4*hi+((lane&15)>>2))*64;
  const char*Kbase=shm+LDS_K; bf16x8 kf[8];
  const lds_cptr shm3=(lds_cptr)shm; const lds_cptr kp0=shm3+LDS_K+hi*1024+r32*16; const lds_cptr vp0=shm3+LDS_V+((lane>>4)&1)*32+(lane&3)*8+(4*hi+((lane&15)>>2))*64;
  const int NT=(q0+QB)/KVBLK;
  { typedef __attribute__((address_space(3))) float* lds_fptr; typedef float f32x2g __attribute__((ext_vector_type(2)));
    int t_=threadIdx.x; asm volatile("":"+v"(t_));
    const f32x2g kmv=((const f32x2g*)kmean_bh)[t_]; float btv=0.f; if(t_<132)btv=biast_h[t_];
    *(__attribute__((address_space(3))) f32x2g*)((lds_fptr)(shm3+LDS_KM)+2*t_)=kmv; if(t_<132)((lds_fptr)(shm3+LDS_BT))[t_]=btv; }
  DMA_K(0,0);DMA_V(0,0);DMA_K(1,SLOTB);
  bf16x8 qr[4];
  #pragma unroll
  for(int d0=0;d0<4;++d0)qr[d0]=*reinterpret_cast<const bf16x8*>(&Qw[(long)r32*PQ+d0*16+hi*8]);
  float mhat=0.f,l_reg=0.f;f32x16 o[2];o[0]=f32x16{};o[1]=f32x16{};f32x16 negm=f32x16{};asm volatile("":"+v"(negm));
  const int qrel=wid*QBLK+r32; const int qabs=q0+qrel; unsigned selmask=0u;
  const lds_cfptr btL=(lds_cfptr)(shm3+LDS_BT);
  #define SETBASE(t) do{ const int j_=(t)>>2; const bool on_=(j_>=qb)||(((selmask>>j_)&1u)!=0u); const float cbase= on_ ? (((t)>=NT-6)?0.f:bfar) : -1e30f; \
    _Pragma("unroll") for(int r=0;r<16;++r)negm[r]=cbase-mhat; asm volatile("":"+v"(negm)); }while(0)
  #define CMASK(P0,P1,t) do{ if((t)>=NT-6){ cbias(P0,P1,btL,qabs-64*(t)-4*hi); int jb_=(t)-(NT-4); if(jb_>=0)cmask(P0,P1,jb_,qrel,hi);} }while(0)
  bool resc=false;
  #define START(P0,P1) do{ const float rm=rowmax(P0,P1); resc=false; \
    { const float dl=max2f(rm,0.f); mhat=fadd_s(mhat,dl); \
      _Pragma("unroll") for(int r=0;r<16;++r){P0[r]=fsub_s(P0[r],dl);P1[r]=fsub_s(P1[r],dl);} \
      { const float nn_=negm[0]-dl; _Pragma("unroll") for(int r=0;r<16;++r)negm[r]=nn_; } asm volatile("":"+v"(negm)); } \
    _Pragma("unroll") for(int r=0;r<16;++r)P0[r]=__builtin_amdgcn_exp2f(P0[r]); }while(0)
  #define RESC() do{ if(resc){ asm volatile("s_waitcnt lgkmcnt(0)":::"memory"); \
      _Pragma("unroll") for(int d_=0;d_<2;++d_) _Pragma("unroll") for(int r=0;r<16;++r)o[d_][r]*=wsf[crow(r,hi)]; } }while(0)
  f32x16 pA0,pA1,pB0,pB1;
  int sl_prev=0,sl_cur=0,sl_next=SLOTB;
  #define ROT() do{sl_prev=sl_cur;sl_cur=sl_next;sl_next=(sl_next==(NSLOT-1)*SLOTB)?0:sl_next+SLOTB;}while(0)
  DMA_K(2,2*SLOTB);
  WAIT_BAR(3);
  const float bfar=btL[128];
  if(qb<=3) selmask=(1u<<qb)-1u;
  else{ const lds_cfptr kmL=(lds_cfptr)(shm3+LDS_KM); float g0=-INFINITY,g1=-INFINITY,g2=-INFINITY; int i0=0,i1=0,i2=0;
    for(int j=0;j<qb;++j){ float g=0.f;
      #pragma unroll
      for(int d0=0;d0<4;++d0){ const lds_cfptr kp_=kmL+j*64+d0*16+hi*8;
        #pragma unroll
        for(int e=0;e<8;++e) g+=__builtin_bit_cast(float,((unsigned)(unsigned short)qr[d0][e])<<16)*kp_[e]; }
      g+=__shfl_xor(g,32);
      if(g>g0){g2=g1;i2=i1;g1=g0;i1=i0;g0=g;i0=j;} else if(g>g1){g2=g1;i2=i1;g1=g;i1=j;} else if(g>g2){g2=g;i2=j;} }
    selmask=(1u<<i0)|(1u<<i1)|(1u<<i2); }
  SETBASE(0);
  qkt(pA0,pA1,Kbase,qr,negm,r32,hi);asm volatile("s_nop 15\n\ts_nop 7":"+v"(pA0),"+v"(pA1));CMASK(pA0,pA1,0);
  START(pA0,pA1);
  _Pragma("unroll") for(int r=0;r<16;++r)pA1[r]=__builtin_amdgcn_exp2f(pA1[r]);
  WAIT_BAR(0);
  DMA_K(3,0);DMA_V(1,SLOTB);
  ROT();
  kload8(kf,kp0+sl_cur);
  WAIT_BAR(2);
  s16x4 vlo[8],vhi[8]; u32x4 pw0,pw1,pw2,pw3;
  #define PKW(P,B) cvtpk_s(P[B],P[B+1])
  #define PAF(k) __builtin_bit_cast(bf16x8,pw##k)
  #define VFR(i) (bf16x8){vlo[i][0],vlo[i][1],vlo[i][2],vlo[i][3],vhi[i][0],vhi[i][1],vhi[i][2],vhi[i][3]}
  #define PIN(x) asm volatile("":"+v"(x))
  #define MX3(a,b,c) __builtin_fmaxf(__builtin_fmaxf((a),(b)),(c))
  #define GAPA(MF,A0,A1,A2,A3,W0,W1,PW) do{ MF; sacc+=A0; sacc+=A1; sacc+=A2; sacc+=A3; PIN(sacc); W0; W1; PIN(PW); SBAR(); }while(0)
  #define EX(v) __builtin_amdgcn_exp2f(v)
  #define GAPB(MF,X,B) do{ MF; X[B]=EX(X[B]); X[B+1]=EX(X[B+1]); X[B+2]=EX(X[B+2]); X[B+3]=EX(X[B+3]); PIN(X); SBAR(); }while(0)
  #define VRD(i) do{ vlo[i]=vtr(vp_+(((i)>>2)*4096+((i)&3)*1024)); vhi[i]=vtr(vp_+(((i)>>2)*4096+((i)&3)*1024+512)); }while(0)
  #define KRD(G,j) do{ if(G){ kload2(kf,kp0+sl_next,j); SBAR(); } }while(0)
  #define STEP(C0,C1,P0,P1,t,GK,GV,GL) do{ SBAR(); \
    const lds_cptr vp_=vp0+sl_prev; \
    VRD(0); SBAR(); float sacc=(P0[0]+P0[1]); \
    GAPA(C0=__builtin_amdgcn_mfma_f32_32x32x16_bf16(kf[0],qr[0],negm,0,0,0), P0[2],P0[3],P0[4],P0[5],     pw0[0]=PKW(P0,0), pw0[1]=PKW(P0,2), pw0); \
    VRD(4); SBAR(); GAPA(C1=__builtin_amdgcn_mfma_f32_32x32x16_bf16(kf[1],qr[0],negm,0,0,0), P0[6],P0[7],P0[8],P0[9],     pw0[2]=PKW(P0,4), pw0[3]=PKW(P0,6), pw0); \
    VRD(1); SBAR(); GAPA(C0=__builtin_amdgcn_mfma_f32_32x32x16_bf16(kf[2],qr[1],C0,0,0,0),   P0[10],P0[11],P0[12],P0[13], pw1[0]=PKW(P0,8), pw1[1]=PKW(P0,10), pw1); \
    VRD(5); SBAR(); GAPA(C1=__builtin_amdgcn_mfma_f32_32x32x16_bf16(kf[3],qr[1],C1,0,0,0),   P0[14],P0[15],P1[0],P1[1],   pw1[2]=PKW(P0,12),pw1[3]=PKW(P0,14), pw1); \
    VRD(2); SBAR(); GAPA(C0=__builtin_amdgcn_mfma_f32_32x32x16_bf16(kf[4],qr[2],C0,0,0,0),   P1[2],P1[3],P1[4],P1[5],     pw2[0]=PKW(P1,0), pw2[1]=PKW(P1,2), pw2); \
    VRD(6); SBAR(); GAPA(C1=__builtin_amdgcn_mfma_f32_32x32x16_bf16(kf[5],qr[2],C1,0,0,0),   P1[6],P1[7],P1[8],P1[9],     pw2[2]=PKW(P1,4), pw2[3]=PKW(P1,6), pw2); \
    VRD(3); SBAR(); GAPA(C0=__builtin_amdgcn_mfma_f32_32x32x16_bf16(kf[6],qr[3],C0,0,0,0),   P1[10],P1[11],P1[12],P1[13], pw3[0]=PKW(P1,8), pw3[1]=PKW(P1,10), pw3); \
    VRD(7); SBAR(); GAPA(C1=__builtin_amdgcn_mfma_f32_32x32x16_bf16(kf[7],qr[3],C1,0,0,0),   P1[14],P1[15],0.f,0.f,       pw3[2]=PKW(P1,12),pw3[3]=PKW(P1,14), pw3); \
    l_reg+=sacc; \
    if(GK){DMA_K((t)+3,sl_cur);} if(GV){DMA_V((t)+1,sl_next);} \
    CMASK(C0,C1,t); \
    { float a=MX3(C0[0],C0[1],C1[0]),b=MX3(C0[2],C0[3],C1[1]); a=MX3(a,C1[2],C1[3]); \
      _Pragma("unroll") for(int r=4;r<16;r+=4){a=MX3(a,C0[r],C0[r+1]);b=MX3(b,C0[r+2],C0[r+3]);a=MX3(a,C1[r],C1[r+1]);b=MX3(b,C1[r+2],C1[r+3]);} \
      float rm=__builtin_fmaxf(a,b); { auto rr=__builtin_amdgcn_permlane32_swap(__float_as_uint(rm),__float_as_uint(rm),false,false); rm=__builtin_fmaxf(__uint_as_float(rr[0]),__uint_as_float(rr[1])); } \
      resc=false; \
      if(__builtin_expect(__any(rm>(float)THRL),0)){ const float dl=__builtin_fmaxf(rm,0.f); mhat+=dl; \
        _Pragma("unroll") for(int r=0;r<16;++r){C0[r]-=dl;C1[r]-=dl;} \
        { const float nn_=negm[0]-dl; _Pragma("unroll") for(int r=0;r<16;++r)negm[r]=nn_; } asm volatile("":"+v"(negm)); \
        const float f=__builtin_amdgcn_exp2f(-dl); l_reg*=f; if(hi==0)wsf[r32]=f; resc=true; } } \
    SBAR(); \
    GAPB(o[0]=__builtin_amdgcn_mfma_f32_32x32x16_bf16(PAF(0),VFR(0),o[0],0,0,0), C0,0); \
    GAPB(o[1]=__builtin_amdgcn_mfma_f32_32x32x16_bf16(PAF(0),VFR(4),o[1],0,0,0), C0,4); \
    KRD(GL,0); GAPB(o[0]=__builtin_amdgcn_mfma_f32_32x32x16_bf16(PAF(1),VFR(1),o[0],0,0,0), C0,8); \
    KRD(GL,1); GAPB(o[1]=__builtin_amdgcn_mfma_f32_32x32x16_bf16(PAF(1),VFR(5),o[1],0,0,0), C0,12); \
    KRD(GL,2); GAPB(o[0]=__builtin_amdgcn_mfma_f32_32x32x16_bf16(PAF(2),VFR(2),o[0],0,0,0), C1,0); \
    KRD(GL,3); GAPB(o[1]=__builtin_amdgcn_mfma_f32_32x32x16_bf16(PAF(2),VFR(6),o[1],0,0,0), C1,4); \
    GAPB(o[0]=__builtin_amdgcn_mfma_f32_32x32x16_bf16(PAF(3),VFR(3),o[0],0,0,0), C1,8); \
    GAPB(o[1]=__builtin_amdgcn_mfma_f32_32x32x16_bf16(PAF(3),VFR(7),o[1],0,0,0), C1,12); \
    }while(0)
  int t=1;
  #undef CMASK
  #define CMASK(P0,P1,t) do{}while(0)
  for(;t+7<NT;t+=2){
    STEP(pB0,pB1,pA0,pA1,t,true,true,true);     WAIT_BAR(2); RESC(); ROT();
    if(((t+1)&3)==0){SETBASE(t+1);}
    STEP(pA0,pA1,pB0,pB1,t+1,true,true,true);   WAIT_BAR(2); RESC(); ROT();
  }
  #undef CMASK
  #define CMASK(P0,P1,t) do{ if((t)>=NT-6){ cbias(P0,P1,btL,qabs-64*(t)-4*hi); int jb_=(t)-(NT-4); if(jb_>=0)cmask(P0,P1,jb_,qrel,hi);} }while(0)
  #define ENDW(tt) do{ if((tt)+3<NT){WAIT_BAR(2);} else if((tt)+2<NT){WAIT_BAR(1);} else {WAIT_BAR(0);} }while(0)
  for(;t+1<NT;t+=2){
    STEP(pB0,pB1,pA0,pA1,t,(t+3<NT),(t+1<NT),(t+1<NT));       ENDW(t);   RESC(); ROT();
    SETBASE(t+1);
    STEP(pA0,pA1,pB0,pB1,t+1,(t+4<NT),(t+2<NT),(t+2<NT));     ENDW(t+1); RESC(); ROT();
  }
  STEP(pB0,pB1,pA0,pA1,NT-1,false,false,false); RESC();
  { float sacc=pB0[0]+pB0[1]; _Pragma("unroll") for(int r=2;r<16;++r)sacc+=pB0[r]; _Pragma("unroll") for(int r=0;r<16;++r)sacc+=pB1[r]; l_reg+=sacc;
    pw0=(u32x4){PKW(pB0,0),PKW(pB0,2),PKW(pB0,4),PKW(pB0,6)};pw1=(u32x4){PKW(pB0,8),PKW(pB0,10),PKW(pB0,12),PKW(pB0,14)};pw2=(u32x4){PKW(pB1,0),PKW(pB1,2),PKW(pB1,4),PKW(pB1,6)};pw3=(u32x4){PKW(pB1,8),PKW(pB1,10),PKW(pB1,12),PKW(pB1,14)};
    SBAR(); pv(o,vb0+sl_cur,PAF(0),PAF(1),PAF(2),PAF(3)); }
  #undef PKW
  #undef PAF
  #undef VFR
  #undef PIN
  #undef MX3
  #undef GAPA
  #undef GAPB
  #undef EX
  #undef VRD
  #undef KRD
  #undef STEP
  #undef ENDW
  {auto rr=__builtin_amdgcn_permlane32_swap(__float_as_uint(l_reg),__float_as_uint(l_reg),false,false);l_reg=__uint_as_float(rr[0])+__uint_as_float(rr[1]);}
  if(hi==0)wsf[32+r32]=l_reg;asm volatile("s_waitcnt lgkmcnt(0)":::"memory");
  float rli[16];
  #pragma unroll
  for(int r=0;r<16;++r)rli[r]=__builtin_amdgcn_rcpf(wsf[32+crow(r,hi)]);
  bf16*Ow=O+(rowbase+q0+wid*QBLK)*PO+h*D;
  { bf16*stg=(bf16*)(shm+LDS_OST)+wid*2048;
    #pragma unroll
    for(int r=0;r<16;++r){const int orow=crow(r,hi);
      #pragma unroll
      for(int d0=0;d0<2;++d0)stg[orow*64+d0*32+r32]=__float2bfloat16(o[d0][r]*rli[r]);}
    asm volatile("s_waitcnt lgkmcnt(0)":::"memory");
    #pragma unroll
    for(int i=0;i<4;++i){const int row=i*8+(lane>>3),ch=lane&7; const u32x4 v=*(const u32x4*)(stg+row*64+ch*8); ATTN_STORE16(Ow+(long)row*PO+ch*8,v);} }
  asm volatile("s_waitcnt lgkmcnt(0)\n\ts_barrier":::"memory");
  #undef DMA_K
  #undef DMA_V
  #undef CMASK
  #undef START
  #undef RESC
  #undef ROT
  #undef SETBASE
}
constexpr int ATTN_LDS_BYTES=LDS_TOTAL;
struct AttnTensors { const bf16* Q; const bf16* K; const bf16* V; bf16* O; const float* kmean; const float* biast; };
struct AttnUnit { int bh; int qb; };
struct StaticOrder {
  int vcu;
  __device__ __forceinline__ explicit StaticOrder(int grid,int block):vcu((block%8)*(grid/8)+block/8){}
  __device__ __forceinline__ bool next(int i,AttnUnit&u)const{ if(i>=4)return false; const int s=vcu&3; u.bh=vcu>>2; u.qb=(i==0)?15-s:(i==1)?8+s:(i==2)?7-s:s; return true; }
  __device__ __forceinline__ void a_ready(const AttnUnit&)const{}
  __device__ __forceinline__ void done(const AttnUnit&)const{}
};
template<class Sched,int THRL=8> __device__ __forceinline__ void attn_phase(char*lds,const AttnTensors&T,const Sched&S){
  AttnUnit u;
  for(int i=0;S.next(i,u);++i){ S.a_ready(u); attn_unit<THRL>(u.bh/NHEAD,u.bh%NHEAD,u.qb,T.Q,T.K,T.V,T.O,T.kmean+(size_t)u.bh*1024,T.biast+(u.bh%NHEAD)*132,lds); S.done(u); }
}
#undef SBAR
#undef WAIT_BAR
}
typedef short bf16x8v __attribute__((ext_vector_type(8)));
typedef float f32x16v __attribute__((ext_vector_type(16)));
typedef float f32x2v_ __attribute__((ext_vector_type(2)));
typedef unsigned u32x2v_ __attribute__((ext_vector_type(2)));
__device__ __forceinline__ int crow_(int r, int hi) { return (r & 3) + 8 * (r >> 2) + 4 * hi; }
__device__ __forceinline__ unsigned cvtpk(float lo, float hi) { typedef __bf16 bf2 __attribute__((ext_vector_type(2))); f32x2v_ v = {lo, hi}; bf2 b = __builtin_convertvector(v, bf2); return __builtin_bit_cast(unsigned, b); }
__device__ __forceinline__ bf16x8v pack8(const float (&x)[8]) { v4u w; w.x = cvtpk(x[0], x[1]); w.y = cvtpk(x[2], x[3]); w.z = cvtpk(x[4], x[5]); w.w = cvtpk(x[6], x[7]); return __builtin_bit_cast(bf16x8v, w); }
__device__ __forceinline__ void unpack8(v4u w, float (&x)[8]) {
#pragma unroll
    for (int e = 0; e < 4; ++e) { x[2 * e] = bflo(w[e]); x[2 * e + 1] = bfhi(w[e]); } }
#define WG_SYNC() __syncthreads()

__device__ __forceinline__ void kmean_unit(LAS unsigned char* shm, int b, int blk, const bf16* PROJ, float* KMEAN, int tid, int wave, int lane) {
    float acc[8];
#pragma unroll
    for (int e = 0; e < 8; ++e) acc[e] = 0.f;
    const bf16* base = PROJ + ((size_t)b * SEQ + blk * 256) * LDP + C_MK + 8 * lane;
#pragma unroll 8
    for (int i = 0; i < 32; ++i) { const v4u w = *(const GAS v4u*)(base + (size_t)(wave + 8 * i) * LDP); float x[8]; unpack8(w, x);
#pragma unroll
        for (int e = 0; e < 8; ++e) acc[e] += x[e]; }
    LAS float* red = (LAS float*)shm;
#pragma unroll
    for (int e = 0; e < 8; ++e) red[wave * 512 + lane * 8 + e] = acc[e];
    WG_SYNC();
    float s = 0.f;
#pragma unroll
    for (int w = 0; w < 8; ++w) s += red[w * 512 + tid];
    KMEAN[(((size_t)b * 8 + (tid >> 6)) * 16 + blk) * 64 + (tid & 63)] = s * (1.0f / 256.0f);
    WG_SYNC();
}

constexpr int LRU_XCF = 0, LRU_RG = 32768, LRU_IG = 65536, LRU_XCB = 98304, LRU_XCB_LD = 264;
template <bool FINAL>
__device__ __forceinline__ void lru_unit(LAS unsigned char* shm, int b, int c, const bf16* PROJ, const bf16* WaT, const bf16* WxT, const float* cw, const float* cb,
                                         const float* ba, const float* bx, const float* lam, float* SUMM, bf16* MIX, int tid, int wave, int lane) {
    LAS float* XCF = (LAS float*)(shm + LRU_XCF); LAS float* RG = (LAS float*)(shm + LRU_RG); LAS float* IG = (LAS float*)(shm + LRU_IG); LAS bf16* XCB = (LAS bf16*)(shm + LRU_XCB);
    const int r32 = lane & 31, hi = lane >> 5;
    const int g = wave >> 1, typ = wave & 1;
    bf16x8v Bf[2][4];
    { const bf16* W = (typ ? WxT : WaT) + (size_t)g * 4096;
#pragma unroll
      for (int nt = 0; nt < 2; ++nt)
#pragma unroll
          for (int ks = 0; ks < 4; ++ks) Bf[nt][ks] = *(const GAS bf16x8v*)(W + (32 * nt + r32) * 64 + 16 * ks + 8 * hi); }
    const float bias0 = (typ ? bx : ba)[g * 64 + r32], bias1 = (typ ? bx : ba)[g * 64 + 32 + r32];
    float hst = 0.f, aprod = 1.f, k8 = 0.f;
    if (tid < 256) { k8 = 8.0f * softplusf_(-lam[tid]);
        if (FINAL) { for (int cc = 0; cc < c; ++cc) { const float* sp = SUMM + ((size_t)(b * 32 + cc) * 2) * 256; hst = sp[tid] * hst + sp[256 + tid]; } } }
    const int tt = tid >> 4, c0 = (tid & 15) * 16;
    for (int sb = 0; sb < 4; ++sb) {
        const int t0 = c * 128 + sb * 32; const size_t row0 = (size_t)b * SEQ + t0;
        { float xc[16];
#pragma unroll
          for (int e = 0; e < 16; ++e) xc[e] = cb[c0 + e];
#pragma unroll
          for (int j = 0; j < 4; ++j) { const int t = t0 + tt - 3 + j;
              if (t >= 0) { const bf16* xp = PROJ + ((size_t)b * SEQ + t) * LDP + C_LX + c0; const v4u w0 = *(const GAS v4u*)xp, w1 = *(const GAS v4u*)(xp + 8);
                  float x0[8], x1[8]; unpack8(w0, x0); unpack8(w1, x1);
#pragma unroll
                  for (int e = 0; e < 8; ++e) { xc[e] += cw[j * 256 + c0 + e] * x0[e]; xc[8 + e] += cw[j * 256 + c0 + 8 + e] * x1[e]; } } }
#pragma unroll
          for (int q4 = 0; q4 < 4; ++q4) *(LAS f32x4*)(XCF + tt * 256 + c0 + 4 * q4) = (f32x4){xc[4 * q4], xc[4 * q4 + 1], xc[4 * q4 + 2], xc[4 * q4 + 3]};
          float a8[8], b8[8];
#pragma unroll
          for (int e = 0; e < 8; ++e) { a8[e] = xc[e]; b8[e] = xc[8 + e]; }
          *(LAS bf16x8v*)(XCB + tt * LRU_XCB_LD + c0) = pack8(a8); *(LAS bf16x8v*)(XCB + tt * LRU_XCB_LD + c0 + 8) = pack8(b8); }
        WG_SYNC();
        { f32x16v acc0 = {}, acc1 = {};
#pragma unroll
          for (int ks = 0; ks < 4; ++ks) { const bf16x8v Af = *(const LAS bf16x8v*)(XCB + r32 * LRU_XCB_LD + g * 64 + 16 * ks + 8 * hi);
              acc0 = __builtin_amdgcn_mfma_f32_32x32x16_bf16(Af, Bf[0][ks], acc0, 0, 0, 0); acc1 = __builtin_amdgcn_mfma_f32_32x32x16_bf16(Af, Bf[1][ks], acc1, 0, 0, 0); }
          LAS float* dst = typ ? IG : RG;
#pragma unroll
          for (int r = 0; r < 16; ++r) { const int tok = crow_(r, hi);
              dst[tok * 256 + g * 64 + r32] = sigmoidf_(acc0[r] + bias0); dst[tok * 256 + g * 64 + 32 + r32] = sigmoidf_(acc1[r] + bias1); } }
        WG_SYNC();
        if (tid < 256) {
#pragma unroll 4
            for (int i = 0; i < 32; ++i) { const float r = RG[i * 256 + tid], ig = IG[i * 256 + tid], xv = XCF[i * 256 + tid];
                const float log_a = -k8 * r; const float a = __expf(log_a); float mult = sqrtf(-expm1f(2.0f * log_a)); if (t0 + i == 0) mult = 1.0f;
                hst = a * hst + mult * (ig * xv); aprod *= a;
                if (FINAL) { const float gate = bf2f(PROJ[(row0 + i) * LDP + C_LG + tid]); const float u = 0.7978845608028654f * (gate + 0.044715f * gate * gate * gate);
                    MIX[(row0 + i) * DM + tid] = (bf16)f2bf(hst * gate / (1.0f + __expf(-2.0f * u))); } } }
        WG_SYNC();
    }
    if (!FINAL && tid < 256) { float* sp = SUMM + ((size_t)(b * 32 + c) * 2) * 256; sp[tid] = aprod; sp[256 + tid] = hst; }
}

constexpr int GLA_PW = 14336, GLA_VT = 0, GLA_VT_LD = 72, GLA_KW = 9216, GLA_KW_LD = 40, GLA_DEC = 8 * GLA_PW;
constexpr int GLA_SUM = 2112;
template <bool FINAL>
__device__ __forceinline__ void gla_unit(LAS unsigned char* shm, int b, int h, int grp, const bf16* PROJ, const float* gb, const float* gn, float* GSUM, bf16* MIX, int tid, int wave, int lane) {
    const int r32 = lane & 31, hi = lane >> 5;
    LAS unsigned char* pw = shm + wave * GLA_PW;
    LAS float* CUM = (LAS float*)pw; LAS bf16* VT = (LAS bf16*)(pw + GLA_VT); LAS bf16* KW = (LAS bf16*)(pw + GLA_KW); LAS float* DEC = (LAS float*)(shm + GLA_DEC);
    const size_t R0 = (size_t)b * SEQ + grp * 512 + wave * 64;
#pragma unroll
    for (int tt = 0; tt < 2; ++tt)
#pragma unroll
        for (int ks = 0; ks < 2; ++ks) { const int tok = 32 * tt + r32, d0 = 16 * ks + 8 * hi;
            const v4u w = *(const GAS v4u*)(PROJ + (R0 + tok) * LDP + C_GZ + h * 32 + d0); float z[8]; unpack8(w, z);
            const f32x4 g0 = *(const GAS f32x4*)(gb + h * 32 + d0), g1 = *(const GAS f32x4*)(gb + h * 32 + d0 + 4);
            float la[8];
#pragma unroll
            for (int e = 0; e < 8; ++e) { const float zz = z[e] + (e < 4 ? g0[e] : g1[e - 4]); la[e] = -softplusf_(-zz) * (1.0f / 16.0f); }
            *(LAS f32x4*)(CUM + tok * 32 + d0) = (f32x4){la[0], la[1], la[2], la[3]}; *(LAS f32x4*)(CUM + tok * 32 + d0 + 4) = (f32x4){la[4], la[5], la[6], la[7]}; }
    LDS_WAIT(); asm volatile("" ::: "memory");
    float lastd;
    { float v[32];
#pragma unroll
      for (int i = 0; i < 32; ++i) v[i] = CUM[(32 * hi + i) * 32 + r32];
#pragma unroll
      for (int i = 1; i < 32; ++i) v[i] += v[i - 1];
      const float tot0 = __shfl(v[31], r32);
      if (hi) {
#pragma unroll
          for (int i = 0; i < 32; ++i) v[i] += tot0; }
      lastd = __shfl(v[31], 32 + r32);
#pragma unroll
      for (int i = 0; i < 32; ++i) CUM[(32 * hi + i) * 32 + r32] = v[i]; }
    LDS_WAIT(); asm volatile("" ::: "memory");
    const float decay = __expf(lastd);
    bf16x8v qdB[2][2], kdA[2][2];
#pragma unroll
    for (int tt = 0; tt < 2; ++tt)
#pragma unroll
        for (int ks = 0; ks < 2; ++ks) { const int tok = 32 * tt + r32, d0 = 16 * ks + 8 * hi;
            const f32x4 c0 = *(const LAS f32x4*)(CUM + tok * 32 + d0), c1 = *(const LAS f32x4*)(CUM + tok * 32 + d0 + 4);
            const f32x4 l0 = *(const LAS f32x4*)(CUM + 63 * 32 + d0), l1 = *(const LAS f32x4*)(CUM + 63 * 32 + d0 + 4);
            const v4u wq = *(const GAS v4u*)(PROJ + (R0 + tok) * LDP + C_GQ + h * 32 + d0), wk = *(const GAS v4u*)(PROJ + (R0 + tok) * LDP + C_GK + h * 32 + d0);
            float q[8], k[8], qd[8], kd[8], kw[8]; unpack8(wq, q); unpack8(wk, k);
#pragma unroll
            for (int e = 0; e < 8; ++e) { const float cu = e < 4 ? c0[e] : c1[e - 4], la = e < 4 ? l0[e] : l1[e - 4];
                qd[e] = q[e] * __expf(cu); kd[e] = k[e] * __expf(-cu); kw[e] = k[e] * __expf(la - cu); }
            qdB[tt][ks] = pack8(qd); kdA[tt][ks] = pack8(kd);
            *(LAS bf16x8v*)(KW + tok * GLA_KW_LD + d0) = pack8(kw); }
    LDS_WAIT(); asm volatile("" ::: "memory");
#pragma unroll
    for (int i = 0; i < 8; ++i) { const int p = i * 64 + lane, tok = p >> 3, ch = p & 7;
        const v4u w = *(const GAS v4u*)(PROJ + (R0 + tok) * LDP + C_GV + h * 64 + ch * 8); *(LAS v4u*)(VT + tok * GLA_VT_LD + ch * 8) = w; }
    LDS_WAIT(); asm volatile("" ::: "memory");
    bf16x8v vtA[2][4];
#pragma unroll
    for (int mv = 0; mv < 2; ++mv)
#pragma unroll
        for (int kk = 0; kk < 4; ++kk) { bf16x8v f;
#pragma unroll
            for (int j = 0; j < 8; ++j) f[j] = (short)VT[(16 * kk + 8 * (j >> 2) + 4 * hi + (j & 3)) * GLA_VT_LD + 32 * mv + r32];
            vtA[mv][kk] = f; }
    f32x16v kvT[2] = {{}, {}};
#pragma unroll
    for (int kk = 0; kk < 4; ++kk) { bf16x8v f;
#pragma unroll
        for (int j = 0; j < 8; ++j) f[j] = (short)KW[(16 * kk + 8 * (j >> 2) + 4 * hi + (j & 3)) * GLA_KW_LD + r32];
        kvT[0] = __builtin_amdgcn_mfma_f32_32x32x16_bf16(vtA[0][kk], f, kvT[0], 0, 0, 0); kvT[1] = __builtin_amdgcn_mfma_f32_32x32x16_bf16(vtA[1][kk], f, kvT[1], 0, 0, 0); }
    LDS_WAIT(); asm volatile("" ::: "memory");
    { LAS float* KV = (LAS float*)pw;
#pragma unroll
      for (int mv = 0; mv < 2; ++mv)
#pragma unroll
          for (int r = 0; r < 16; ++r) KV[(mv * 16 + r) * 64 + lane] = kvT[mv][r];
      DEC[wave * 64 + lane] = decay; }
    f32x16v oT[2][2] = {{{}, {}}, {{}, {}}};
    if (FINAL) {
#pragma unroll
        for (int mt = 0; mt < 2; ++mt)
#pragma unroll
            for (int nt = 0; nt < 2; ++nt) {
                if (mt == 1 && nt == 0) continue;
                f32x16v at = {};
#pragma unroll
                for (int ks = 0; ks < 2; ++ks) at = __builtin_amdgcn_mfma_f32_32x32x16_bf16(kdA[mt][ks], qdB[nt][ks], at, 0, 0, 0);
                if (mt == nt) {
#pragma unroll
                    for (int r = 0; r < 16; ++r) if (crow_(r, hi) > r32) at[r] = 0.f; }
#pragma unroll
                for (int s = 0; s < 2; ++s) { float x[8];
#pragma unroll
                    for (int j = 0; j < 8; ++j) x[j] = at[8 * s + j];
                    const bf16x8v bfr = pack8(x);
                    oT[0][nt] = __builtin_amdgcn_mfma_f32_32x32x16_bf16(vtA[0][2 * mt + s], bfr, oT[0][nt], 0, 0, 0);
                    oT[1][nt] = __builtin_amdgcn_mfma_f32_32x32x16_bf16(vtA[1][2 * mt + s], bfr, oT[1][nt], 0, 0, 0); } }
    }
    WG_SYNC();
    float S[32];
#pragma unroll
    for (int i = 0; i < 32; ++i) S[i] = 0.f;
    float dprod = 1.0f;
    if (FINAL) { for (int gq = 0; gq < grp; ++gq) { const float* sp = GSUM + (size_t)((b * 4 + h) * 8 + gq) * GLA_SUM; const float dg = sp[2048 + lane];
#pragma unroll
            for (int i = 0; i < 32; ++i) S[i] = dg * S[i] + sp[i * 64 + lane]; } }
    const int nfold = FINAL ? wave : 8;
    if (FINAL || wave == 7) {
        for (int n = 0; n < nfold; ++n) { const LAS float* KVn = (const LAS float*)(shm + n * GLA_PW); const float dn = DEC[n * 64 + lane]; dprod *= dn;
#pragma unroll
            for (int i = 0; i < 32; ++i) S[i] = dn * S[i] + KVn[i * 64 + lane]; } }
    if (!FINAL) {
        if (wave == 7) { float* sp = GSUM + (size_t)((b * 4 + h) * 8 + grp) * GLA_SUM;
#pragma unroll
            for (int i = 0; i < 32; ++i) sp[i * 64 + lane] = S[i];
            sp[2048 + lane] = dprod; }
        WG_SYNC();
        return;
    }
    WG_SYNC();
    { LAS bf16* ST = KW;
#pragma unroll
      for (int mv = 0; mv < 2; ++mv)
#pragma unroll
          for (int r = 0; r < 16; ++r) ST[(32 * mv + crow_(r, hi)) * GLA_KW_LD + r32] = (bf16)f2bf(S[mv * 16 + r]);
      LDS_WAIT(); asm volatile("" ::: "memory");
#pragma unroll
      for (int mv = 0; mv < 2; ++mv)
#pragma unroll
          for (int ks = 0; ks < 2; ++ks) { const bf16x8v sa = *(const LAS bf16x8v*)(ST + (32 * mv + r32) * GLA_KW_LD + 16 * ks + 8 * hi);
              oT[mv][0] = __builtin_amdgcn_mfma_f32_32x32x16_bf16(sa, qdB[0][ks], oT[mv][0], 0, 0, 0); oT[mv][1] = __builtin_amdgcn_mfma_f32_32x32x16_bf16(sa, qdB[1][ks], oT[mv][1], 0, 0, 0); } }
#pragma unroll
    for (int nt = 0; nt < 2; ++nt) { float ss = 0.f;
#pragma unroll
        for (int mv = 0; mv < 2; ++mv)
#pragma unroll
            for (int r = 0; r < 16; ++r) ss += oT[mv][nt][r] * oT[mv][nt][r];
        ss += __shfl_xor(ss, 32);
        const float rstd = 1.0f / sqrtf(ss * (1.0f / 64.0f) + RMS_EPS);
        const size_t row = R0 + 32 * nt + r32;
#pragma unroll
        for (int mv = 0; mv < 2; ++mv)
#pragma unroll
            for (int rg = 0; rg < 4; ++rg) { const int v0 = 32 * mv + 8 * rg + 4 * hi;
                const u32x2v_ gw = *(const GAS u32x2v_*)(PROJ + row * LDP + C_GO + h * 64 + v0); const f32x4 gg = *(const GAS f32x4*)(gn + h * 64 + v0);
                const float go[4] = {bflo(gw.x), bfhi(gw.x), bflo(gw.y), bfhi(gw.y)}; float y[4];
#pragma unroll
                for (int e = 0; e < 4; ++e) y[e] = oT[mv][nt][4 * rg + e] * rstd * gg[e] * (go[e] / (1.0f + __expf(-go[e])));
                u32x2v_ ow; ow.x = cvtpk(y[0], y[1]); ow.y = cvtpk(y[2], y[3]);
                *(GAS u32x2v_*)(MIX + row * DM + 256 + h * 64 + v0) = ow; } }
    WG_SYNC();
}

#define NAIVE_SETUP \
    const int tid = threadIdx.x; const int G = gridDim.x, gt = blockIdx.x * 256 + tid, NGT = G * 256; unsigned char* ws = args.ws; \
    bf16* PROJ = (bf16*)(ws + WS_PROJ); bf16* MIX = (bf16*)(ws + WS_MIX); float* Y = (float*)(ws + WS_Y); \
    float* KMEAN = (float*)(ws + WS_KMEAN); float* BIAST = (float*)(ws + WS_BIAS); \
    float* XC = Y; float* AA = Y + (size_t)M * 256; float* UU = Y + (size_t)2 * M * 256; float* OGLA = Y + (size_t)3 * M * 256; \
    (void)tid; (void)PROJ; (void)MIX; (void)KMEAN; (void)BIAST; (void)XC; (void)AA; (void)UU; (void)OGLA;
__global__ void __launch_bounds__(256) naive_a1(Args args, int l, int nf) { NAIVE_SETUP
            if (nf & 1) for (int i = gt; i < BATCH * 8 * 16 * 64; i += NGT) { const int d = i & 63, blk = (i >> 6) & 15, h = (i >> 10) & 7, b = i >> 13;
                const bf16* p = PROJ + ((size_t)b * SEQ + blk * 256) * LDP + C_MK + h * 64 + d; float s = 0.f;
                for (int r = 0; r < 256; ++r) s += bf2f(p[(size_t)r * LDP]);
                KMEAN[i] = s * (1.0f / 256.0f); }
            if (nf & 2) { const float* cw = args.in[7] + (size_t)l * 4 * 256; const float* cb = args.in[8] + (size_t)l * 256;
              for (size_t i = gt; i < (size_t)M * 256; i += NGT) { const int c = (int)(i & 255); const size_t row = i >> 8; const int t = (int)(row % SEQ);
                float s = cb[c];
#pragma unroll
                for (int j = 0; j < 4; ++j) { const int tt = t - 3 + j; if (tt >= 0) s += cw[j * 256 + c] * bf2f(PROJ[(row - 3 + j) * LDP + C_LX + c]); }
                XC[i] = s; } }
            if (nf & 4) { const float* gb = args.in[15] + (size_t)l * 128;
              for (int i = gt; i < BATCH * 4 * 64; i += NGT) { const int v = i & 63, h = (i >> 6) & 3, b = i >> 8;
                float Sd[32], gbv[32];
#pragma unroll
                for (int d = 0; d < 32; ++d) { Sd[d] = 0.f; gbv[d] = gb[h * 32 + d]; }
                for (int t = 0; t < SEQ; ++t) { const size_t row = (size_t)b * SEQ + t; const bf16* pr = PROJ + row * LDP;
                    const float vv = bf2f(pr[C_GV + h * 64 + v]); float o = 0.f;
                    const v4u* qp = (const v4u*)(pr + C_GQ + h * 32); const v4u* kp = (const v4u*)(pr + C_GK + h * 32); const v4u* zp = (const v4u*)(pr + C_GZ + h * 32);
#pragma unroll
                    for (int c4 = 0; c4 < 4; ++c4) { const v4u qq = qp[c4], kk = kp[c4], zz = zp[c4];
#pragma unroll
                        for (int e = 0; e < 4; ++e) {
#pragma unroll
                            for (int hl = 0; hl < 2; ++hl) { const int d = c4 * 8 + e * 2 + hl;
                                const float qf = hl ? bfhi(qq[e]) : bflo(qq[e]), kf = hl ? bfhi(kk[e]) : bflo(kk[e]), zf = (hl ? bfhi(zz[e]) : bflo(zz[e])) + gbv[d];
                                const float la = -softplusf_(-zf) * (1.0f / 16.0f); const float al = __expf(la);
                                Sd[d] = al * Sd[d] + kf * vv; o += qf * Sd[d]; } } }
                    OGLA[row * 256 + h * 64 + v] = o; } } }
}
__global__ void __launch_bounds__(256) naive_a2(Args args, int l) { NAIVE_SETUP
            const float* wa = args.in[9] + (size_t)l * 4 * 64 * 64; const float* ba = args.in[10] + (size_t)l * 256;
            const float* wx = args.in[11] + (size_t)l * 4 * 64 * 64; const float* bx = args.in[12] + (size_t)l * 256; const float* lam = args.in[13] + (size_t)l * 256;
            for (size_t i = gt; i < (size_t)M * 256; i += NGT) { const int c = (int)(i & 255), g = c >> 6, j = c & 63; const size_t row = i >> 8; const int t = (int)(row % SEQ);
                const float* xr = XC + row * 256 + g * 64; float sr = ba[c], si = bx[c];
                for (int k = 0; k < 64; ++k) { const float xv = xr[k]; sr += xv * wa[(g * 64 + k) * 64 + j]; si += xv * wx[(g * 64 + k) * 64 + j]; }
                const float r = sigmoidf_(sr), ig = sigmoidf_(si);
                const float log_a = -8.0f * r * softplusf_(-lam[c]);
                const float a = __expf(log_a); float mult = sqrtf(-expm1f(2.0f * log_a)); if (t == 0) mult = 1.0f;
                AA[i] = a; UU[i] = mult * (ig * XC[i]); }
}
__global__ void __launch_bounds__(256) naive_c1(Args args, int l, int nf) { NAIVE_SETUP
            if (nf & 2) for (int i = gt; i < BATCH * 256; i += NGT) { const int c = i & 255, b = i >> 8; float h = 0.f;
                for (int t = 0; t < SEQ; ++t) { const size_t row = (size_t)b * SEQ + t; h = AA[row * 256 + c] * h + UU[row * 256 + c];
                    const float gate = bf2f(PROJ[row * LDP + C_LG + c]); MIX[row * DM + c] = (bf16)f2bf(h * gelu_tanh(gate)); } }
            if (nf & 4) { const float* gn = args.in[16] + (size_t)l * 256;
              for (size_t i = gt; i < (size_t)M * 4; i += NGT) { const int h = (int)(i & 3); const size_t row = i >> 2; const float* o = OGLA + row * 256 + h * 64; float ss = 0.f;
                for (int v = 0; v < 64; ++v) ss += o[v] * o[v];
                const float rs = 1.0f / sqrtf(ss * (1.0f / 64.0f) + RMS_EPS);
                for (int v = 0; v < 64; ++v) { const float go = bf2f(PROJ[row * LDP + C_GO + h * 64 + v]); MIX[row * DM + 256 + h * 64 + v] = (bf16)f2bf(o[v] * rs * gn[h * 64 + v] * (go * sigmoidf_(go))); } } }

}
__global__ void __launch_bounds__(256) naive_c2(Args args, int l) { NAIVE_SETUP
            for (int i = gt; i < BATCH * 8 * SEQ; i += NGT) { const int q = i % SEQ, h = (i / SEQ) & 7, b = i / (SEQ * 8);
                const size_t row = (size_t)b * SEQ + q; float qv[64];
                { const v4u* qp = (const v4u*)(PROJ + row * LDP + C_MQ + h * 64);
#pragma unroll
                  for (int c8 = 0; c8 < 8; ++c8) { const v4u w = qp[c8];
#pragma unroll
                      for (int e = 0; e < 4; ++e) { qv[c8 * 8 + e * 2] = bflo(w[e]); qv[c8 * 8 + e * 2 + 1] = bfhi(w[e]); } } }
                const int nb = q >> 8; unsigned selmask;
                if (nb <= 3) selmask = (1u << nb) - 1u;
                else { float g0 = -INFINITY, g1 = -INFINITY, g2 = -INFINITY; int i0 = 0, i1 = 0, i2 = 0;
                    for (int j = 0; j < nb; ++j) { const float* km = KMEAN + (((size_t)b * 8 + h) * 16 + j) * 64; float gsum = 0.f;
#pragma unroll
                        for (int d = 0; d < 64; ++d) gsum += qv[d] * km[d];
                        if (gsum > g0) { g2 = g1; i2 = i1; g1 = g0; i1 = i0; g0 = gsum; i0 = j; } else if (gsum > g1) { g2 = g1; i2 = i1; g1 = gsum; i1 = j; } else if (gsum > g2) { g2 = gsum; i2 = j; } }
                    selmask = (1u << i0) | (1u << i1) | (1u << i2); }
                float mx = -1e30f, lsum = 0.f, o[64];
#pragma unroll
                for (int d = 0; d < 64; ++d) o[d] = 0.f;
                const float* bt = BIAST + h * 132;
                for (int j = 0; j <= nb; ++j) { if (j < nb && !((selmask >> j) & 1u)) continue;
                    const int kend = (j == nb) ? (q & 255) : 255;
                    for (int kk = 0; kk <= kend; ++kk) { const int kpos = j * 256 + kk; const bf16* kr = PROJ + ((size_t)b * SEQ + kpos) * LDP;
                        const v4u* kp = (const v4u*)(kr + C_MK + h * 64); float s = 0.f;
#pragma unroll
                        for (int c8 = 0; c8 < 8; ++c8) { const v4u w = kp[c8];
#pragma unroll
                            for (int e = 0; e < 4; ++e) s += qv[c8 * 8 + e * 2] * bflo(w[e]) + qv[c8 * 8 + e * 2 + 1] * bfhi(w[e]); }
                        const int dist = q - kpos; s += bt[dist < 128 ? dist : 128];
                        if (s > mx) { const float sc = __builtin_amdgcn_exp2f(mx - s); lsum *= sc;
#pragma unroll
                            for (int d = 0; d < 64; ++d) o[d] *= sc;
                            mx = s; }
                        const float p = __builtin_amdgcn_exp2f(s - mx); lsum += p;
                        const v4u* vp = (const v4u*)(kr + C_MV + h * 64);
#pragma unroll
                        for (int c8 = 0; c8 < 8; ++c8) { const v4u w = vp[c8];
#pragma unroll
                            for (int e = 0; e < 4; ++e) { o[c8 * 8 + e * 2] += p * bflo(w[e]); o[c8 * 8 + e * 2 + 1] += p * bfhi(w[e]); } } } }
                const float inv = 1.0f / lsum; v4u* op = (v4u*)(MIX + row * DM + 512 + h * 64);
#pragma unroll
                for (int c8 = 0; c8 < 8; ++c8) { v4u w;
#pragma unroll
                    for (int e = 0; e < 4; ++e) w[e] = pk2(o[c8 * 8 + e * 2] * inv, o[c8 * 8 + e * 2 + 1] * inv);
                    op[c8] = w; } }
}

typedef const __attribute__((address_space(4))) Args CArgs;
struct Ctx { CArgs* ap; XcdBarrier bar; LAS unsigned char* ldsp; unsigned char* lds; };
#define IN(k) (lo <= (k) && (k) < hi)
template <int l> __device__ __forceinline__ void layer_body(const Ctx& C) {
    CArgs* ap = C.ap; const XcdBarrier bar = C.bar; LAS unsigned char* ldsp = C.ldsp; unsigned char* lds = C.lds; const int G = gridDim.x, NGW = G * NWAVES, NGT = G * NTHR; (void)NGT; (void)NGW;
    unsigned char* ws = ap->ws; const int lo = ap->ph_lo, hi = ap->ph_hi, flags = ap->flags & EXP_MASK;
    const float* x_in = ap->in[0]; float* xres = ap->out;
    bf16* XN = (bf16*)(ws + WS_XN); bf16* PROJ = (bf16*)(ws + WS_PROJ); bf16* HFF = (bf16*)(ws + WS_PROJ); bf16* MIX = (bf16*)(ws + WS_MIX); float* Y = (float*)(ws + WS_Y);
    float* KMEAN = (float*)(ws + WS_KMEAN); float* BIAST = (float*)(ws + WS_BIAS); float* LRUSUM = (float*)(ws + WS_LRUSUM); float* GLASUM = (float*)(ws + WS_GLASUM);
        const int pb = 1 + 8 * l;
        unsigned char* wl = ws + WS_W + (size_t)l * W_LAYER;
        const bf16* Win_t = (const bf16*)(wl + WO_IN); const bf16* Wout_t = (const bf16*)(wl + WO_OUT); const bf16* Wgu_t = (const bf16*)(wl + WO_GU); const bf16* Wd_t = (const bf16*)(wl + WO_D);
        const float* xprev = (l == 0) ? x_in : xres;

        if (IN(pb + 0)) { asm volatile("" : "+s"(ap)); int tid = threadIdx.x; asm volatile("" : "+v"(tid)); const int lane = tid & 63, wave = __builtin_amdgcn_readfirstlane(tid >> 6), gw = blockIdx.x * NWAVES + wave, gt = blockIdx.x * NTHR + tid; (void)lane; (void)gw; (void)gt;
            pg8::Gemm g{XN, Win_t, M, LDP, DM}; pg8::StaticOrder S; S.init(M, LDP, G, (int)blockIdx.x);
            pg8::EpiBf16<0> E{PROJ, LDP, nullptr, 0, 0, 1.f};
            pg8::gemm_phase<pg8::EpiBf16<0>, pg8::StaticOrder, true, true>(ldsp, g, S, E);
            if (IN(pb + 0 + 1)) { xcd_barrier(bar); }
        }
        if (IN(pb + 1)) { asm volatile("" : "+s"(ap)); int tid = threadIdx.x; asm volatile("" : "+v"(tid)); const int lane = tid & 63, wave = __builtin_amdgcn_readfirstlane(tid >> 6), gw = blockIdx.x * NWAVES + wave, gt = blockIdx.x * NTHR + tid; (void)lane; (void)gw; (void)gt;
            if (flags & 1) for (int u = blockIdx.x; u < BATCH * 16; u += G) kmean_unit(ldsp, u >> 4, u & 15, PROJ, KMEAN, tid, wave, lane);
            if (flags & 2) { const bf16* WaT = (const bf16*)(ws + WS_LRUW) + (size_t)l * 32768; const bf16* WxT = WaT + 16384;
                for (int u = blockIdx.x; u < BATCH * 32; u += G) lru_unit<false>(ldsp, u >> 5, u & 31, PROJ, WaT, WxT, ap->in[7] + (size_t)l * 1024, ap->in[8] + (size_t)l * 256,
                    ap->in[10] + (size_t)l * 256, ap->in[12] + (size_t)l * 256, ap->in[13] + (size_t)l * 256, LRUSUM, MIX, tid, wave, lane); }
            if (flags & 4) for (int u = blockIdx.x; u < BATCH * 32; u += G) gla_unit<false>(ldsp, u >> 5, (u >> 3) & 3, u & 7, PROJ, ap->in[15] + (size_t)l * 128, ap->in[16] + (size_t)l * 256, GLASUM, MIX, tid, wave, lane);
            if (IN(pb + 1 + 1)) { xcd_barrier(bar); }
        }
        if (IN(pb + 2)) { asm volatile("" : "+s"(ap)); int tid = threadIdx.x; asm volatile("" : "+v"(tid)); const int lane = tid & 63, wave = __builtin_amdgcn_readfirstlane(tid >> 6), gw = blockIdx.x * NWAVES + wave, gt = blockIdx.x * NTHR + tid; (void)lane; (void)gw; (void)gt;
            if (flags & 2) { const bf16* WaT = (const bf16*)(ws + WS_LRUW) + (size_t)l * 32768; const bf16* WxT = WaT + 16384;
                for (int u = blockIdx.x; u < BATCH * 32; u += G) lru_unit<true>(ldsp, u >> 5, u & 31, PROJ, WaT, WxT, ap->in[7] + (size_t)l * 1024, ap->in[8] + (size_t)l * 256,
                    ap->in[10] + (size_t)l * 256, ap->in[12] + (size_t)l * 256, ap->in[13] + (size_t)l * 256, LRUSUM, MIX, tid, wave, lane); }
            if (flags & 4) for (int u = blockIdx.x; u < BATCH * 32; u += G) gla_unit<true>(ldsp, u >> 5, (u >> 3) & 3, u & 7, PROJ, ap->in[15] + (size_t)l * 128, ap->in[16] + (size_t)l * 256, GLASUM, MIX, tid, wave, lane);
            if ((flags & 8) && G == 256) {
                const attn_body::AttnTensors AT{(const attn_body::bf16*)(PROJ + C_MQ), (const attn_body::bf16*)(PROJ + C_MK), (const attn_body::bf16*)(PROJ + C_MV), (attn_body::bf16*)(MIX + 512), KMEAN, BIAST};
                const attn_body::StaticOrder S((int)G, (int)blockIdx.x);
                attn_body::attn_phase<attn_body::StaticOrder>((char*)lds, AT, S);
            }
            if (IN(pb + 2 + 1)) { xcd_barrier(bar); }
        }
        if (IN(pb + 3)) { asm volatile("" : "+s"(ap)); int tid = threadIdx.x; asm volatile("" : "+v"(tid)); const int lane = tid & 63, wave = __builtin_amdgcn_readfirstlane(tid >> 6), gw = blockIdx.x * NWAVES + wave, gt = blockIdx.x * NTHR + tid; (void)lane; (void)gw; (void)gt;
            pg8::Gemm g{MIX, Wout_t, M, DM, DM}; pg8::StaticOrder S; S.init(M, DM, G, (int)blockIdx.x);
            pg8::EpiF32 E{Y, DM, nullptr};
            pg8::gemm_phase<pg8::EpiF32, pg8::StaticOrder, true, true>(ldsp, g, S, E);
            if (IN(pb + 3 + 1)) { xcd_barrier(bar); }
        }
        if (IN(pb + 4)) { asm volatile("" : "+s"(ap)); int tid = threadIdx.x; asm volatile("" : "+v"(tid)); const int lane = tid & 63, wave = __builtin_amdgcn_readfirstlane(tid >> 6), gw = blockIdx.x * NWAVES + wave, gt = blockIdx.x * NTHR + tid; (void)lane; (void)gw; (void)gt;
            const float* gpost = ap->in[2] + (size_t)l * DM; const float* gnext = ap->in[3] + (size_t)l * DM;
            for (int m = gw; m < M; m += NGW) resnorm_row(Y + (size_t)m * DM, xprev + (size_t)m * DM, gpost, xres + (size_t)m * DM, gnext, XN + (size_t)m * DM, lane);
            if (IN(pb + 4 + 1)) { xcd_barrier(bar); }
        }
        if (IN(pb + 5)) { asm volatile("" : "+s"(ap)); int tid = threadIdx.x; asm volatile("" : "+v"(tid)); const int lane = tid & 63, wave = __builtin_amdgcn_readfirstlane(tid >> 6), gw = blockIdx.x * NWAVES + wave, gt = blockIdx.x * NTHR + tid; (void)lane; (void)gw; (void)gt;
            pg8::Gemm g{XN, Wgu_t, M, NGU, DM}; pg8::StaticOrder S; S.init(M, NGU, G, (int)blockIdx.x);
            pg8::EpiSwiGLU E{HFF, DFF};
            pg8::gemm_phase<pg8::EpiSwiGLU, pg8::StaticOrder, true, true>(ldsp, g, S, E);
            if (IN(pb + 5 + 1)) { xcd_barrier(bar); }
        }
        if (IN(pb + 6)) { asm volatile("" : "+s"(ap)); int tid = threadIdx.x; asm volatile("" : "+v"(tid)); const int lane = tid & 63, wave = __builtin_amdgcn_readfirstlane(tid >> 6), gw = blockIdx.x * NWAVES + wave, gt = blockIdx.x * NTHR + tid; (void)lane; (void)gw; (void)gt;
            pg8::Gemm g{HFF, Wd_t, M, DM, DFF}; pg8::StaticOrder S; S.init(M, DM, G, (int)blockIdx.x);
            pg8::EpiF32 E{Y, DM, nullptr};
            pg8::gemm_phase<pg8::EpiF32, pg8::StaticOrder, true, true>(ldsp, g, S, E);
            if (IN(pb + 6 + 1)) { xcd_barrier(bar); }
        }
        if (IN(pb + 7)) { asm volatile("" : "+s"(ap)); int tid = threadIdx.x; asm volatile("" : "+v"(tid)); const int lane = tid & 63, wave = __builtin_amdgcn_readfirstlane(tid >> 6), gw = blockIdx.x * NWAVES + wave, gt = blockIdx.x * NTHR + tid; (void)lane; (void)gw; (void)gt;
            const float* gpost = ap->in[4] + (size_t)l * DM; const float* gnext = (l + 1 < NLAYER) ? ap->in[1] + (size_t)(l + 1) * DM : nullptr;
            for (int m = gw; m < M; m += NGW) resnorm_row(Y + (size_t)m * DM, xres + (size_t)m * DM, gpost, xres + (size_t)m * DM, gnext, XN + (size_t)m * DM, lane);
            if (IN(pb + 7 + 1)) { xcd_barrier(bar); }
        }
}
#undef IN

__global__ void __launch_bounds__(NTHR, 2) mk_fwd(Args args) {
    extern __shared__ __attribute__((aligned(16))) unsigned char lds[];
    LAS unsigned char* ldsp = (LAS unsigned char*)lds;
    const int tid = threadIdx.x, lane = tid & 63, wave = __builtin_amdgcn_readfirstlane(tid >> 6);
    const int G = gridDim.x, gw = blockIdx.x * NWAVES + wave, NGW = G * NWAVES, gt = blockIdx.x * NTHR + tid, NGT = G * NTHR;
    unsigned char* ws = args.ws;
    const int lo = args.ph_lo, hi = args.ph_hi;
#define IN(k) (lo <= (k) && (k) < hi)
    const float* x_in = args.in[0];
    float* xres = args.out;
    bf16* XN = (bf16*)(ws + WS_XN); bf16* PROJ = (bf16*)(ws + WS_PROJ); bf16* HFF = (bf16*)(ws + WS_PROJ); bf16* MIX = (bf16*)(ws + WS_MIX); float* Y = (float*)(ws + WS_Y);
    float* KMEAN = (float*)(ws + WS_KMEAN); float* BIAST = (float*)(ws + WS_BIAS); float* LRUSUM = (float*)(ws + WS_LRUSUM); float* GLASUM = (float*)(ws + WS_GLASUM);
    for (int u = tid; u < (LDS_BYTES - LDSCTL_OFF) / 4; u += NTHR) ((LAS unsigned*)(ldsp + LDSCTL_OFF))[u] = 0u;
    __syncthreads();
    const XcdBarrier bar = xcd_barrier_post((unsigned*)(ws + WS_CTL) + CW_BAR, (volatile LAS unsigned*)(ldsp + MISC_OFF) + 8);

    if (IN(0)) {
        LAS float* scr = (LAS float*)(ldsp + wave * 16384);
        for (int l = 0; l < NLAYER; ++l) {
            unsigned char* wl = ws + WS_W + (size_t)l * W_LAYER;
            bf16* Win_t = (bf16*)(wl + WO_IN); bf16* Wout_t = (bf16*)(wl + WO_OUT); bf16* Wgu_t = (bf16*)(wl + WO_GU); bf16* Wd_t = (bf16*)(wl + WO_D);
            const float* w_in = args.in[5] + (size_t)l * DM * D_IN; const float* w_out = args.in[6] + (size_t)l * DM * DM;
            const float* w2 = args.in[14] + (size_t)l * 16 * 128;
            const float* wg = args.in[18] + (size_t)l * DM * DFF; const float* wu = args.in[19] + (size_t)l * DM * DFF; const float* wd = args.in[20] + (size_t)l * DFF * DM;
            constexpr int KB = DM / 64;
            constexpr int I_IN = (LDP / 32) * KB, I_OUT = (DM / 32) * KB, I_GU = (NGU / 32) * KB, I_D = (DM / 32) * (DFF / 64);
            for (int it = gw; it < I_IN + I_OUT + I_GU + I_D; it += NGW) {
                int r = it;
                if (r < I_IN) { const int nb = r / KB, kb = r % KB, n0 = nb * 32;
                    if (n0 < 2816) { const int s0 = n0 < 1024 ? n0 : n0 + 16; const float sc = (n0 >= C_GQ && n0 < C_GK) ? GLA_QS : ((n0 >= C_MQ && n0 < C_MK) ? MOBA_C2 : 1.0f);
                        tr_item(w_in, D_IN, s0, DM, Win_t, n0, kb * 64, sc, scr, lane); }
                    else if (n0 < 2944) trz_item(w_in, w2, Win_t, n0, n0 - 2816, kb * 64, scr, lane);
                    else { const int c = lane & 7;
#pragma unroll
                        for (int j = 0; j < 4; ++j) { const int n = (lane >> 3) + 8 * j; *(GAS v4u*)(Win_t + (size_t)(n0 + n) * DM + kb * 64 + 8 * c) = (v4u){0u, 0u, 0u, 0u}; } }
                    continue; }
                r -= I_IN;
                if (r < I_OUT) { const int nb = r / KB, kb = r % KB; tr_item(w_out, DM, nb * 32, DM, Wout_t, nb * 32, kb * 64, 1.0f, scr, lane); continue; }
                r -= I_OUT;
                if (r < I_GU) { const int nb = r / KB, kb = r % KB, n0 = nb * 32, pn = n0 >> 8, within = n0 & 255;
                    if (within < 128) tr_item(wg, DFF, pn * 128 + within, DM, Wgu_t, n0, kb * 64, 1.0f, scr, lane);
                    else tr_item(wu, DFF, pn * 128 + within - 128, DM, Wgu_t, n0, kb * 64, 1.0f, scr, lane);
                    continue; }
                r -= I_GU;
                { constexpr int KBD = DFF / 64; const int nb = r / KBD, kb = r % KBD; tr_item(wd, DM, nb * 32, DFF, Wd_t, nb * 32, kb * 64, 1.0f, scr, lane); }
            }
        }
        for (int i = gt; i < NLAYER * 2 * 16384; i += NGT) { const int l = i >> 15, which = (i >> 14) & 1, g = (i >> 12) & 3, j = (i >> 6) & 63, k = i & 63;
            ((bf16*)(ws + WS_LRUW))[i] = (bf16)f2bf(args.in[which ? 11 : 9][(size_t)l * 16384 + (g * 64 + k) * 64 + j]); }
        for (int i = gt; i < 8 * 132; i += NGT) { const int h = i / 132, d = i % 132; BIAST[i] = args.in[17][t5_bucket(d < 128 ? d : 128) * 8 + h] * LOG2E; }
        for (int m = gw; m < M; m += NGW) norm_row(x_in + (size_t)m * DM, args.in[1], XN + (size_t)m * DM, lane);
        if (IN(1)) { xcd_barrier(bar); }
    }

    { Ctx C{(CArgs*)__builtin_amdgcn_kernarg_segment_ptr(), bar, ldsp, lds}; layer_body<0>(C); layer_body<1>(C); }
#undef IN
}

extern "C" void kernel_launch(void* const* d_in, const int* in_sizes, int n_in, void* d_out, int out_size, void* d_ws, size_t ws_size, hipStream_t stream) {
    static int grid = 0;
    if (grid == 0) {
        if (n_in != 21 || in_sizes[0] != M * DM || out_size != M * DM || ws_size < WS_END) { fprintf(stderr, "kernel_launch: unexpected shapes (n_in %d in0 %d out %d ws %zu)\n", n_in, n_in > 0 ? in_sizes[0] : -1, out_size, ws_size); grid = -1; return; }
        if (hipFuncSetAttribute((const void*)mk_fwd, hipFuncAttributeMaxDynamicSharedMemorySize, LDS_BYTES) != hipSuccess) { fprintf(stderr, "kernel_launch: hipFuncSetAttribute failed\n"); grid = -1; return; }
        int dev = 0, cus = 0;
        if (hipGetDevice(&dev) != hipSuccess || hipDeviceGetAttribute(&cus, hipDeviceAttributeMultiprocessorCount, dev) != hipSuccess) { grid = -1; return; }
        (void)hipGetLastError();
        grid = cus;
    }
    if (grid < 0) return;
    (void)hipMemsetAsync((char*)d_ws + WS_CTL, 0, CTL_ZERO_BYTES, stream);
    Args a{};
    for (int i = 0; i < 21; ++i) a.in[i] = (const float*)d_in[i];
    a.out = (float*)d_out; a.ws = (unsigned char*)d_ws;
    constexpr int FAST = FAST_FLAGS;
    a.flags = FAST; a.pad = 0;
    const int nf = (~FAST) & 15;
    if (nf == 0) { a.ph_lo = 0; a.ph_hi = 17; hipLaunchKernelGGL(mk_fwd, dim3(grid), dim3(NTHR), LDS_BYTES, stream, a); return; }
    for (int p = 0; p < 17; ++p) {
        const int r = (p - 1) % 8, l = (p - 1) / 8;
        if (p >= 1 && r == 1 && (nf & 7)) { hipLaunchKernelGGL(naive_a1, dim3(2048), dim3(256), 0, stream, a, l, nf); if (nf & 2) hipLaunchKernelGGL(naive_a2, dim3(2048), dim3(256), 0, stream, a, l); }
        if (p >= 1 && r == 2) { if (nf & 6) hipLaunchKernelGGL(naive_c1, dim3(2048), dim3(256), 0, stream, a, l, nf); if (nf & 8) hipLaunchKernelGGL(naive_c2, dim3(2048), dim3(256), 0, stream, a, l); }
        a.ph_lo = p; a.ph_hi = p + 1; hipLaunchKernelGGL(mk_fwd, dim3(grid), dim3(NTHR), LDS_BYTES, stream, a); }
}
```

```cpp
#include <hip/hip_runtime.h>
#include <cstdio>
#include <cstdint>
namespace pg8 {
#define PG8_LAS __attribute__((address_space(3)))
typedef unsigned short bf16_t;
typedef short bf16x8 __attribute__((ext_vector_type(8)));
typedef float f32x4 __attribute__((ext_vector_type(4)));
typedef unsigned u32x4 __attribute__((ext_vector_type(4)));
constexpr int BM = 256, BK = 64, HALF = 128, HTB = HALF * BK * 2  , STAGE_BYTES = 8 * HTB, NXCD = 8, WGM = 8;

__host__ __device__ __forceinline__ int lds_byte(int r, int c) { const int st = (r >> 4) * 2 + (c >> 5), rr = r & 15, cc = c & 31, ob = rr * 64 + cc * 2; return st * 1024 + (ob ^ (((ob >> 9) & 1) << 5)); }
__host__ __device__ __forceinline__ void stage_rc(int b, int& R, int& C) { const int st = b / 1024, sb = b % 1024, swz = sb ^ (((sb >> 9) & 1) << 5); R = (st >> 1) * 16 + swz / 64; C = (st & 1) * 32 + (swz % 64) / 2; }
__host__ __device__ __forceinline__ int perm32(int rho) { const int n = rho >> 4, i = rho & 15; return 8 * (i >> 2) + 4 * n + (i & 3); }

struct Unit { int pm, pn; };
struct Gemm { const bf16_t* A; const bf16_t* Bt; int M, N, K; };

struct StaticOrder {
    int nM, nN, nwg, G, c;
    __host__ __device__ void init(int M, int N, int G_, int c_) { nM = M / BM; nN = N / BM; nwg = nM * nN; G = G_; c = c_; }
    __host__ __device__ bool next(int i, Unit& u) const {
        const long L = (long)i * G + c; if (L >= nwg) return false;
        int wgid = (int)L; { const int q = nwg / NXCD, r = nwg % NXCD, xcd = wgid % NXCD, off = wgid / NXCD; wgid = (xcd < r ? xcd * (q + 1) : r * (q + 1) + (xcd - r) * q) + off; }
        const int nig = WGM * nN, gid = wgid / nig, fm = gid * WGM, gsz = (nM - fm) < WGM ? (nM - fm) : WGM;
        u.pm = fm + ((wgid % nig) % gsz); u.pn = (wgid % nig) / gsz; return true;
    }
    __device__ __forceinline__ void a_ready(const Unit&) const {}
    __device__ __forceinline__ void done(const Unit&) const {}
};

__device__ __forceinline__ unsigned cvt_pk_bf16(float lo, float hi) { unsigned r; asm volatile("v_cvt_pk_bf16_f32 %0, %1, %2" : "=v"(r) : "v"(lo), "v"(hi)); return r; }
typedef float f32x2 __attribute__((ext_vector_type(2)));
struct EpiF32 {
    static constexpr bool PERM = false, AFTER_DRAIN = false;
    float* C; int ldc; const float* bias;
    __device__ __forceinline__ void operator()(const f32x4 (&acc)[2][2][4][2], const Unit& u, int wr, int wc, int fr, int fq) const {
        const int row0 = u.pm * BM + wr * 64 + fr, col0 = u.pn * BM + wc * 32 + 4 * fq;
        f32x4 bv[2][2];
#pragma unroll
        for (int bj = 0; bj < 2; ++bj)
#pragma unroll
            for (int n = 0; n < 2; ++n) bv[bj][n] = bias ? *(const f32x4*)(bias + col0 + bj * HALF + n * 16) : (f32x4){0.f, 0.f, 0.f, 0.f};
#pragma unroll
        for (int ai = 0; ai < 2; ++ai)
#pragma unroll
            for (int m = 0; m < 4; ++m) { float* rowp = C + (size_t)(row0 + ai * HALF + m * 16) * ldc + col0;
#pragma unroll
                for (int bj = 0; bj < 2; ++bj)
#pragma unroll
                    for (int n = 0; n < 2; ++n) *(f32x4*)(rowp + bj * HALF + n * 16) = acc[ai][bj][m][n] + bv[bj][n]; }
    }
};
template <int ACT  > struct EpiBf16 {
    static constexpr bool PERM = true, AFTER_DRAIN = false; static_assert(ACT == 0 || ACT == 1, "EpiBf16: ACT is 0 (none) or 1 (gelu_pk)");
    bf16_t* O; int ldc; const float* bias; int split_cols; size_t split_stride; float scale0;
    __device__ __forceinline__ void operator()(const f32x4 (&acc)[2][2][4][2], const Unit& u, int wr, int wc, int fr, int fq) const {
        const int row0 = u.pm * BM + wr * 64 + fr; int colt = u.pn * BM; bf16_t* base = O;
        float sc = 1.f; if (split_cols) { const int t = colt / split_cols; base += (size_t)t * split_stride; colt -= t * split_cols; if (t == 0) sc = scale0; }
        const int col0 = colt + wc * 32 + 8 * fq, bcol0 = u.pn * BM + wc * 32 + 8 * fq;
        f32x4 bv[2][2];
#pragma unroll
        for (int bj = 0; bj < 2; ++bj)
#pragma unroll
            for (int n = 0; n < 2; ++n) bv[bj][n] = bias ? *(const f32x4*)(bias + bcol0 + bj * HALF + 4 * n) : (f32x4){0.f, 0.f, 0.f, 0.f};
#pragma unroll
        for (int ai = 0; ai < 2; ++ai)
#pragma unroll
            for (int m = 0; m < 4; ++m) { bf16_t* rowp = base + (size_t)(row0 + ai * HALF + m * 16) * ldc + col0;
#pragma unroll
                for (int bj = 0; bj < 2; ++bj) { f32x4 v0 = acc[ai][bj][m][0] + bv[bj][0], v1 = acc[ai][bj][m][1] + bv[bj][1];
                    v0 = v0 * sc; v1 = v1 * sc; u32x4 w; w.x = cvt_pk_bf16(v0[0], v0[1]); w.y = cvt_pk_bf16(v0[2], v0[3]); w.z = cvt_pk_bf16(v1[0], v1[1]); w.w = cvt_pk_bf16(v1[2], v1[3]);
                    *(u32x4*)(rowp + bj * HALF) = w; } }
    }
};
struct EpiSwiGLU {
    static constexpr bool PERM = true, AFTER_DRAIN = false;
    bf16_t* O; int ldc;
    __device__ __forceinline__ void operator()(const f32x4 (&acc)[2][2][4][2], const Unit& u, int wr, int wc, int fr, int fq) const {
        const int row0 = u.pm * BM + wr * 64 + fr, col0 = u.pn * HALF + wc * 32 + 8 * fq;
#pragma unroll
        for (int ai = 0; ai < 2; ++ai)
#pragma unroll
            for (int m = 0; m < 4; ++m) { bf16_t* rowp = O + (size_t)(row0 + ai * HALF + m * 16) * ldc + col0;
                float hv[8];
#pragma unroll
                for (int n = 0; n < 2; ++n)
#pragma unroll
                    for (int i = 0; i < 4; ++i) { const float g = acc[ai][0][m][n][i], up = acc[ai][1][m][n][i];
                        const float e = __builtin_amdgcn_exp2f(g * -1.4426950408889634f); hv[n * 4 + i] = g * __builtin_amdgcn_rcpf(1.0f + e) * up; }
                u32x4 w; w.x = cvt_pk_bf16(hv[0], hv[1]); w.y = cvt_pk_bf16(hv[2], hv[3]); w.z = cvt_pk_bf16(hv[4], hv[5]); w.w = cvt_pk_bf16(hv[6], hv[7]);
                *(u32x4*)rowp = w; }
    }
};
template <class Epi, class Sched, bool ALIGN_EPI = false, bool SP2 = false>
__device__ __forceinline__ void gemm_phase(PG8_LAS unsigned char* lds, const Gemm g, const Sched& S, const Epi& E) {
    const int tid = threadIdx.x, wid = __builtin_amdgcn_readfirstlane(tid >> 6), lane = tid & 63, wr = wid >> 2, wc = wid & 3, fr = lane & 15, fq = lane >> 4;
    const int K = g.K, nt = K / BK;
    unsigned voffA[2], voffB[2];
#pragma unroll
    for (int i = 0; i < 2; ++i) { int R, C; stage_rc(tid * 16 + i * 8192, R, C); const int Rb = Epi::PERM ? ((R & ~31) + perm32(R & 31)) : R;
        voffA[i] = (unsigned)(R * K + C) * 2u; voffB[i] = (unsigned)(Rb * K + C) * 2u; }
    const size_t kstep = (size_t)(BK * 2);
    const size_t hstep = (size_t)HALF * K * 2;
    const size_t tstep = 2 * hstep;
    const unsigned ldsw = (unsigned)wid * 1024u;
    const int aoff = lds_byte(wr * 64 + fr, fq * 8), boff = lds_byte(wc * 32 + fr, fq * 8);
#define PG8_SA(b, h) (((b) * 2 + (h)) * HTB)
#define PG8_SB(b, h) ((4 + (b) * 2 + (h)) * HTB)
#define PG8_STAGE(bufoff, gbase, voff) do { _Pragma("unroll") for (int _i = 0; _i < 2; ++_i) \
        __builtin_amdgcn_global_load_lds((const unsigned*)((const char*)(gbase) + (voff)[_i]), (PG8_LAS unsigned*)(lds + (bufoff) + ldsw + _i * 8192), 16, 0, 0); } while (0)
#define PG8_LDA(dst, b, h) do { _Pragma("unroll") for (int m = 0; m < 4; ++m) _Pragma("unroll") for (int k = 0; k < 2; ++k) dst[m][k] = *(const PG8_LAS bf16x8*)(lds + PG8_SA(b, h) + aoff + m * 2048 + k * 1024); } while (0)
#define PG8_LDB(dst, b, h) do { _Pragma("unroll") for (int n = 0; n < 2; ++n) _Pragma("unroll") for (int k = 0; k < 2; ++k) dst[n][k] = *(const PG8_LAS bf16x8*)(lds + PG8_SB(b, h) + boff + n * 2048 + k * 1024); } while (0)
#define PG8_MMA(ai, bj, At, Bt) do { __builtin_amdgcn_s_setprio(1); _Pragma("unroll") for (int m = 0; m < 4; ++m) _Pragma("unroll") for (int n = 0; n < 2; ++n) _Pragma("unroll") for (int k = 0; k < 2; ++k) \
        acc[ai][bj][m][n] = __builtin_amdgcn_mfma_f32_16x16x32_bf16(Bt[n][k], At[m][k], acc[ai][bj][m][n], 0, 0, 0); __builtin_amdgcn_s_setprio(0); } while (0)
#define PG8_WAIT_V(n) asm volatile("s_waitcnt vmcnt(" #n ")" ::: "memory")
#define PG8_WAIT_L(n) asm volatile("s_waitcnt lgkmcnt(" #n ")" ::: "memory")
#define PG8_BAR __builtin_amdgcn_s_barrier()
#define PG8_SCHED __builtin_amdgcn_sched_barrier(0)
    Unit cur, nxt; int ui = 0;
    if (!S.next(0, cur)) return;
    f32x4 acc[2][2][4][2];
#pragma unroll
    for (int a = 0; a < 2; ++a)
#pragma unroll
        for (int b = 0; b < 2; ++b)
#pragma unroll
            for (int m = 0; m < 4; ++m)
#pragma unroll
                for (int n = 0; n < 2; ++n) acc[a][b][m][n] = (f32x4){0.f, 0.f, 0.f, 0.f};
    bf16x8 At[4][2], B0[2][2], B1[2][2];
    const char* cA = (const char*)g.A + (size_t)cur.pm * tstep; const char* cB = (const char*)g.Bt + (size_t)cur.pn * tstep;
    S.a_ready(cur);
    if constexpr (SP2) {
        PG8_STAGE(PG8_SB(0, 0), cB, voffB); PG8_STAGE(PG8_SB(0, 1), cB + hstep, voffB); PG8_STAGE(PG8_SA(0, 0), cA, voffA); PG8_STAGE(PG8_SA(0, 1), cA + hstep, voffA);
        if (wr == 1) PG8_BAR;
        PG8_WAIT_V(2); PG8_BAR;
        PG8_STAGE(PG8_SB(1, 0), cB + kstep, voffB); PG8_STAGE(PG8_SA(1, 0), cA + kstep, voffA); PG8_STAGE(PG8_SB(1, 1), cB + hstep + kstep, voffB);
        PG8_WAIT_V(6); PG8_BAR;
    } else {
        PG8_STAGE(PG8_SB(0, 0), cB, voffB); PG8_STAGE(PG8_SA(0, 0), cA, voffA); PG8_STAGE(PG8_SB(0, 1), cB + hstep, voffB); PG8_STAGE(PG8_SA(0, 1), cA + hstep, voffA);
        if (wr == 1) PG8_BAR;
        PG8_WAIT_V(4); PG8_BAR;
        PG8_STAGE(PG8_SB(1, 0), cB + kstep, voffB); PG8_STAGE(PG8_SA(1, 0), cA + kstep, voffA); PG8_STAGE(PG8_SB(1, 1), cB + hstep + kstep, voffB);
        PG8_WAIT_V(6); PG8_BAR;
    }
    for (;;) {
        const bool has_next = S.next(ui + 1, nxt);
        const char* nA = has_next ? (const char*)g.A + (size_t)nxt.pm * tstep : cA; const char* nB = has_next ? (const char*)g.Bt + (size_t)nxt.pn * tstep : cB;
        for (int t = 0; t < nt; t += 2) {
            const bool last = (t == nt - 2);
            const char* a1 = cA + (size_t)(t + 1) * kstep;
            const char* a2 = last ? nA : cA + (size_t)(t + 2) * kstep; const char* b2 = last ? nB : cB + (size_t)(t + 2) * kstep;
            const char* a3 = a2 + kstep; const char* b3 = b2 + kstep;
            if (last && has_next) S.a_ready(nxt);
            if constexpr (SP2) {
            PG8_LDB(B0, 0, 0); PG8_LDB(B1, 0, 1); PG8_SCHED; PG8_LDA(At, 0, 0); PG8_STAGE(PG8_SA(1, 1), a1 + hstep, voffA);
            PG8_WAIT_V(8); PG8_WAIT_L(0); PG8_BAR; PG8_MMA(0, 0, At, B0); PG8_MMA(0, 1, At, B1); PG8_BAR; PG8_SCHED;
            PG8_LDA(At, 0, 1); PG8_STAGE(PG8_SB(0, 0), b2, voffB); PG8_STAGE(PG8_SB(0, 1), b2 + hstep, voffB); PG8_STAGE(PG8_SA(0, 0), a2, voffA);
            PG8_WAIT_V(8); PG8_WAIT_L(0); PG8_BAR; PG8_MMA(1, 0, At, B0); PG8_MMA(1, 1, At, B1); PG8_BAR; PG8_SCHED;
            PG8_LDB(B0, 1, 0); PG8_LDB(B1, 1, 1); PG8_SCHED; PG8_LDA(At, 1, 0); PG8_STAGE(PG8_SA(0, 1), a2 + hstep, voffA);
            PG8_WAIT_V(8); PG8_WAIT_L(0); PG8_BAR; PG8_MMA(0, 0, At, B0); PG8_MMA(0, 1, At, B1); PG8_BAR; PG8_SCHED;
            PG8_LDA(At, 1, 1); PG8_STAGE(PG8_SB(1, 0), b3, voffB); PG8_STAGE(PG8_SB(1, 1), b3 + hstep, voffB); PG8_STAGE(PG8_SA(1, 0), a3, voffA);
            PG8_WAIT_V(8); PG8_WAIT_L(0); PG8_BAR; PG8_MMA(1, 0, At, B0); PG8_MMA(1, 1, At, B1); PG8_BAR; PG8_SCHED;
            } else {
            PG8_LDB(B0, 0, 0); PG8_SCHED; PG8_LDA(At, 0, 0); PG8_STAGE(PG8_SA(1, 1), a1 + hstep, voffA);
            PG8_WAIT_L(8); PG8_BAR; PG8_WAIT_L(0); PG8_MMA(0, 0, At, B0); PG8_BAR; PG8_SCHED;
            PG8_LDB(B1, 0, 1); PG8_STAGE(PG8_SB(0, 0), b2, voffB);
            PG8_BAR; PG8_WAIT_L(0); PG8_MMA(0, 1, At, B1); PG8_BAR;
            PG8_LDA(At, 0, 1); PG8_STAGE(PG8_SA(0, 0), a2, voffA);
            PG8_BAR; PG8_WAIT_L(0); PG8_MMA(1, 0, At, B0); PG8_BAR; PG8_SCHED;
            PG8_STAGE(PG8_SB(0, 1), b2 + hstep, voffB);
            PG8_WAIT_V(6); PG8_BAR; PG8_MMA(1, 1, At, B1); PG8_BAR;
            PG8_LDB(B0, 1, 0); PG8_SCHED; PG8_LDA(At, 1, 0); PG8_STAGE(PG8_SA(0, 1), a2 + hstep, voffA);
            PG8_WAIT_L(8); PG8_BAR; PG8_WAIT_L(0); PG8_MMA(0, 0, At, B0); PG8_BAR; PG8_SCHED;
            PG8_LDB(B1, 1, 1); PG8_STAGE(PG8_SB(1, 0), b3, voffB);
            PG8_BAR; PG8_WAIT_L(0); PG8_MMA(0, 1, At, B1); PG8_BAR;
            PG8_LDA(At, 1, 1); PG8_STAGE(PG8_SA(1, 0), a3, voffA);
            PG8_BAR; PG8_WAIT_L(0); PG8_MMA(1, 0, At, B0); PG8_BAR; PG8_SCHED;
            PG8_STAGE(PG8_SB(1, 1), b3 + hstep, voffB);
            PG8_WAIT_V(6); PG8_BAR; PG8_MMA(1, 1, At, B1); PG8_BAR;
            }
        }
        if constexpr (ALIGN_EPI) { if (wr == 0) PG8_BAR; }
        if constexpr (!Epi::AFTER_DRAIN) { E(acc, cur, wr, wc, fr, fq); S.done(cur); }
        if (!has_next) break;
#pragma unroll
        for (int a = 0; a < 2; ++a)
#pragma unroll
            for (int b = 0; b < 2; ++b)
#pragma unroll
                for (int m = 0; m < 4; ++m)
#pragma unroll
                    for (int n = 0; n < 2; ++n) acc[a][b][m][n] = (f32x4){0.f, 0.f, 0.f, 0.f};
        cur = nxt; cA = nA; cB = nB; ++ui;
        if constexpr (ALIGN_EPI) { if (wr == 1) PG8_BAR; }
    }
    PG8_WAIT_V(0);
    if constexpr (!ALIGN_EPI) { if (wr == 0) PG8_BAR; }
    PG8_BAR;
    if constexpr (Epi::AFTER_DRAIN) { E.fused(acc, cur, wr, wc, fr, fq, lds, wid, lane); S.done(cur); }
#undef PG8_SA
#undef PG8_SB
#undef PG8_STAGE
#undef PG8_LDA
#undef PG8_LDB
#undef PG8_MMA
#undef PG8_WAIT_V
#undef PG8_WAIT_L
#undef PG8_BAR
#undef PG8_SCHED
}
}

#ifndef EXP_MASK
#define EXP_MASK 15
#endif
#ifndef FAST_FLAGS
#define FAST_FLAGS 15
#endif
constexpr int NWAVES = 8, NTHR = 512;
constexpr int BATCH = 8, SEQ = 4096, DM = 1024, M = BATCH * SEQ, NLAYER = 2;
constexpr int D_IN = 2832, LDP = 3072, DFF = 2816, NGU = 2 * DFF;
constexpr int C_LX = 0, C_LG = 256, C_GQ = 512, C_GK = 640, C_GV = 768, C_GO = 1024, C_MQ = 1280, C_MK = 1792, C_MV = 2304, C_GZ = 2816;
constexpr float RMS_EPS = 1e-6f;
constexpr float LOG2E = 1.4426950408889634f;
constexpr float MOBA_C2 = 0.125f * LOG2E;
constexpr float GLA_QS = 0.17677669529663687f;

constexpr size_t MiB = 1u << 20;
constexpr size_t WS_CTL = 0, CTL_ZERO_BYTES = 1 * MiB;
constexpr size_t WS_W = 2 * MiB, W_LAYER = 25 * MiB;
constexpr size_t WO_IN = 0, WO_OUT = 6 * MiB, WO_GU = 8 * MiB, WO_D = 19 * MiB;
constexpr size_t WS_MISC = 52 * MiB;
constexpr size_t WS_KMEAN = WS_MISC, WS_BIAS = WS_MISC + 1 * MiB, WS_LRUW = WS_BIAS + 65536  , WS_LRUSUM = WS_MISC + 2 * MiB, WS_GLASUM = WS_MISC + 3 * MiB;
constexpr size_t WS_XN = 64 * MiB, WS_PROJ = 128 * MiB, WS_MIX = 320 * MiB, WS_Y = 384 * MiB, WS_END = 512 * MiB;
constexpr int CW_TMO = 0, CW_CODE = 1, CW_BAR = 4096;

constexpr int RING_BYTES = 131072, LDSCTL_OFF = RING_BYTES, MISC_OFF = LDSCTL_OFF + 320, LDS_BYTES = 147456;

#define GAS __attribute__((address_space(1)))
#define LAS __attribute__((address_space(3)))
typedef unsigned short bf16;
typedef unsigned v4u __attribute__((ext_vector_type(4)));
typedef float f32x4 __attribute__((ext_vector_type(4)));
typedef GAS unsigned gu32;
#define RLX_AGENT __ATOMIC_RELAXED, __HIP_MEMORY_SCOPE_AGENT
#define LDS_WAIT() asm volatile("s_waitcnt lgkmcnt(0)" ::: "memory")
__device__ __forceinline__ unsigned f2bf(float f) { unsigned u = __builtin_bit_cast(unsigned, f); return (u + 0x7fffu + ((u >> 16) & 1u)) >> 16; }
__device__ __forceinline__ unsigned pk2(float lo, float hi) { return f2bf(lo) | (f2bf(hi) << 16); }
__device__ __forceinline__ float bf2f(unsigned v) { return __builtin_bit_cast(float, v << 16); }
__device__ __forceinline__ float bflo(unsigned w) { return __builtin_bit_cast(float, w << 16); }
__device__ __forceinline__ float bfhi(unsigned w) { return __builtin_bit_cast(float, w & 0xffff0000u); }

#define XB_TMO      128
#define XB_XCNT(j)  (256  + 64 * (j))
#define XB_XSUB(j)  (1280 + 64 * (j))
#define XB_XGEN(j)  (2304 + 64 * (j))
#define XB_TOP      3328
#define XB_TOPGEN   3392
#define XCD_BAR_WORDS 3456
#define XB_SPIN_CAP (1u << 18)

__device__ __forceinline__ unsigned xb_ld(unsigned* p)              { return __hip_atomic_load(p, __ATOMIC_RELAXED, __HIP_MEMORY_SCOPE_AGENT); }
__device__ __forceinline__ unsigned xb_add(unsigned* p, unsigned v) { return __hip_atomic_fetch_add(p, v, __ATOMIC_RELAXED, __HIP_MEMORY_SCOPE_AGENT); }
__device__ __forceinline__ unsigned xb_xcc_id() { return (unsigned)__builtin_amdgcn_s_getreg((3 << 11) | 20) & 0xFu; }
#define XB_SPIN(cond, bar) do { unsigned _sp = 0; while (cond) { __builtin_amdgcn_s_sleep(1); \
    if ((++_sp & 255u) == 0u) { if (xb_ld(&(bar)[XB_TMO])) break; if (_sp > XB_SPIN_CAP) { atomicAdd(&(bar)[XB_TMO], 1u); break; } } } } while (0)

struct XcdBarrier {
    unsigned* bar; unsigned x;
    volatile LAS unsigned* st;
};

__device__ __forceinline__ XcdBarrier xcd_barrier_post(unsigned* bar, volatile LAS unsigned* st) {
    XcdBarrier b; b.bar = bar; b.x = xb_xcc_id(); b.st = st;
    if (threadIdx.x == 0) (void)xb_add(&bar[XB_XCNT(b.x)], 1u);
    return b;
}
__device__ __forceinline__ void xcd_barrier_complete(unsigned* bar, unsigned x, unsigned& nloc, unsigned& nx) {
    const unsigned G = gridDim.x * gridDim.y * gridDim.z;
    unsigned sum, cnt, mine, sp = 0u;
    for (;;) {
        sum = 0u; cnt = 0u; mine = 0u;
#pragma unroll
        for (unsigned j = 0; j < 16; ++j) { const unsigned c = xb_ld(&bar[XB_XCNT(j)]); sum += c; cnt += (c > 0u) ? 1u : 0u; mine = (j == x) ? c : mine; }
        if (sum == G) break;
        __builtin_amdgcn_s_sleep(1);
        if ((++sp & 255u) == 0u) { if (xb_ld(&bar[XB_TMO])) break; if (sp > XB_SPIN_CAP) { atomicAdd(&bar[XB_TMO], 1u); break; } }
    }
    nloc = mine > 0u ? mine : 1u; nx = cnt > 0u ? cnt : 1u;
}

__device__ __forceinline__ void xcd_barrier(const XcdBarrier& b) {
    asm volatile("s_waitcnt vmcnt(0)" ::: "memory");
    __syncthreads();
    if (threadIdx.x == 0) {
        unsigned* bar = b.bar;
        __builtin_amdgcn_s_waitcnt(0);
        unsigned nloc = b.st[0], nx = b.st[1];
        if (nloc == 0u) { xcd_barrier_complete(bar, b.x, nloc, nx); b.st[0] = nloc; b.st[1] = nx; }
        const unsigned old = xb_add(&bar[XB_XSUB(b.x)], 1u);
        const unsigned gen = old / nloc;
        if (old + 1u == (gen + 1u) * nloc) {
            __builtin_amdgcn_fence(__ATOMIC_RELEASE, "agent");
            asm volatile("s_waitcnt vmcnt(0)" ::: "memory");
            const unsigned og = xb_add(&bar[XB_TOP], 1u);
            const unsigned tg = og / nx;
            if (og + 1u == (tg + 1u) * nx) xb_add(&bar[XB_TOPGEN], 1u);
            else XB_SPIN(xb_ld(&bar[XB_TOPGEN]) == tg, bar);
            __builtin_amdgcn_fence(__ATOMIC_ACQUIRE, "agent");
            xb_add(&bar[XB_XGEN(b.x)], 1u);
            asm volatile("s_waitcnt vmcnt(0)" ::: "memory");
        } else {
            XB_SPIN(xb_ld(&bar[XB_XGEN(b.x)]) == gen, bar);
            __builtin_amdgcn_fence(__ATOMIC_ACQUIRE, "agent");
            asm volatile("s_waitcnt vmcnt(0)" ::: "memory");
        }
    }
    __syncthreads();
}

__device__ __forceinline__ float wave_sum(float v) {
#pragma unroll
    for (int o = 1; o < 64; o <<= 1) v += __shfl_xor(v, o);
    return v;
}
__device__ __forceinline__ float sigmoidf_(float x) { return 1.0f / (1.0f + __expf(-x)); }
__device__ __forceinline__ float softplusf_(float x) { return fmaxf(x, 0.f) + log1pf(__expf(-fabsf(x))); }
__device__ __forceinline__ float gelu_tanh(float x) { const float u = 0.7978845608028654f * (x + 0.044715f * x * x * x); return 0.5f * x * (1.0f + tanhf(u)); }
__device__ __forceinline__ int t5_bucket(int n) {
    if (n < 16) return n;
    int v = 16;
    v += (n >= 19) + (n >= 21) + (n >= 24) + (n >= 27) + (n >= 31) + (n >= 35) + (n >= 40) + (n >= 46) + (n >= 52) + (n >= 59) + (n >= 67) + (n >= 77) + (n >= 87) + (n >= 99) + (n >= 113);
    return v;
}

__device__ __forceinline__ void tr_item(const float* W, int ldw, int s0, int K, bf16* WT, int n0, int k0, float scale, LAS float* scr, int lane) {
#pragma unroll 8
    for (int i = 0; i < 32; ++i) { const int kk = 2 * i + (lane >> 5); scr[kk * 33 + (lane & 31)] = W[(size_t)(k0 + kk) * ldw + s0 + (lane & 31)] * scale; }
    LDS_WAIT(); asm volatile("" ::: "memory");
    const int c = lane & 7;
#pragma unroll
    for (int j = 0; j < 4; ++j) { const int n = (lane >> 3) + 8 * j; const LAS float* s = scr + (8 * c) * 33 + n;
        v4u o; o.x = pk2(s[0 * 33], s[1 * 33]); o.y = pk2(s[2 * 33], s[3 * 33]); o.z = pk2(s[4 * 33], s[5 * 33]); o.w = pk2(s[6 * 33], s[7 * 33]);
        *(GAS v4u*)(WT + (size_t)(n0 + n) * K + k0 + 8 * c) = o; }
    LDS_WAIT(); asm volatile("" ::: "memory");
}
__device__ __forceinline__ void trz_item(const float* W, const float* w2, bf16* WT, int n0, int j0, int k0, LAS float* scr, int lane) {
    const int n = lane & 31;
    float w2c[16];
#pragma unroll
    for (int r = 0; r < 16; ++r) w2c[r] = w2[r * 128 + j0 + n];
#pragma unroll 4
    for (int i = 0; i < 32; ++i) { const int kk = 2 * i + (lane >> 5); const float* wr = W + (size_t)(k0 + kk) * D_IN + 1024; float s = 0.f;
#pragma unroll
        for (int r = 0; r < 16; ++r) s += wr[r] * w2c[r];
        scr[kk * 33 + n] = s; }
    LDS_WAIT(); asm volatile("" ::: "memory");
    const int c = lane & 7;
#pragma unroll
    for (int j = 0; j < 4; ++j) { const int nn = (lane >> 3) + 8 * j; const LAS float* s = scr + (8 * c) * 33 + nn;
        v4u o; o.x = pk2(s[0 * 33], s[1 * 33]); o.y = pk2(s[2 * 33], s[3 * 33]); o.z = pk2(s[4 * 33], s[5 * 33]); o.w = pk2(s[6 * 33], s[7 * 33]);
        *(GAS v4u*)(WT + (size_t)(n0 + nn) * DM + k0 + 8 * c) = o; }
    LDS_WAIT(); asm volatile("" ::: "memory");
}

struct Args { const float* in[21]; float* out; unsigned char* ws; int ph_lo, ph_hi, flags, pad; };

__device__ __forceinline__ void norm_row(const float* xrow, const float* g, bf16* orow, int lane) {
    const GAS f32x4* xr = (const GAS f32x4*)xrow + lane; const GAS f32x4* gr = (const GAS f32x4*)g + lane;
    f32x4 v[4]; float s = 0.f;
#pragma unroll
    for (int j = 0; j < 4; ++j) { v[j] = xr[64 * j]; s += (v[j].x * v[j].x + v[j].y * v[j].y) + (v[j].z * v[j].z + v[j].w * v[j].w); }
    const float rstd = 1.0f / sqrtf(wave_sum(s) * (1.f / DM) + RMS_EPS);
    GAS unsigned long long* o8 = (GAS unsigned long long*)orow + lane;
#pragma unroll
    for (int j = 0; j < 4; ++j) { const f32x4 gg = gr[64 * j];
        o8[64 * j] = (unsigned long long)pk2(v[j].x * rstd * gg.x, v[j].y * rstd * gg.y) | ((unsigned long long)pk2(v[j].z * rstd * gg.z, v[j].w * rstd * gg.w) << 32); }
}
__device__ __forceinline__ void resnorm_row(const float* yrow, const float* xirow, const float* gpost, float* xorow, const float* gnext, bf16* xnrow, int lane) {
    const GAS f32x4* yr = (const GAS f32x4*)yrow + lane; const GAS f32x4* xr = (const GAS f32x4*)xirow + lane; const GAS f32x4* gp = (const GAS f32x4*)gpost + lane;
    f32x4 v[4]; float s = 0.f;
#pragma unroll
    for (int j = 0; j < 4; ++j) { v[j] = yr[64 * j]; s += (v[j].x * v[j].x + v[j].y * v[j].y) + (v[j].z * v[j].z + v[j].w * v[j].w); }
    const float rstd = 1.0f / sqrtf(wave_sum(s) * (1.f / DM) + RMS_EPS);
    float s2 = 0.f;
#pragma unroll
    for (int j = 0; j < 4; ++j) { const f32x4 xx = xr[64 * j], gg = gp[64 * j]; v[j] = xx + v[j] * rstd * gg; s2 += (v[j].x * v[j].x + v[j].y * v[j].y) + (v[j].z * v[j].z + v[j].w * v[j].w); }
    GAS f32x4* xo = (GAS f32x4*)xorow + lane;
#pragma unroll
    for (int j = 0; j < 4; ++j) xo[64 * j] = v[j];
    if (gnext) {
        const float rstd2 = 1.0f / sqrtf(wave_sum(s2) * (1.f / DM) + RMS_EPS);
        const GAS f32x4* gr = (const GAS f32x4*)gnext + lane; GAS unsigned long long* o8 = (GAS unsigned long long*)xnrow + lane;
#pragma unroll
        for (int j = 0; j < 4; ++j) { const f32x4 gg = gr[64 * j];
            o8[64 * j] = (unsigned long long)pk2(v[j].x * rstd2 * gg.x, v[j].y * rstd2 * gg.y) | ((unsigned long long)pk2(v[j].z * rstd2 * gg.z, v[j].w * rstd2 * gg.w) << 32); }
    }
}


#include <hip/hip_bf16.h>
#include <cmath>
namespace attn_body {
using bf16=__hip_bfloat16;
using bf16x8=__attribute__((ext_vector_type(8)))short;
using s16x4=__attribute__((ext_vector_type(4)))short;
using f32x16=__attribute__((ext_vector_type(16)))float;
using u32x4=__attribute__((ext_vector_type(4)))unsigned;
constexpr int BATCH=8,NHEAD=8,SEQ=4096,D=64,PQ=3072,PO=1024;
constexpr int NW=8,QBLK=32,QB=QBLK*NW,KVBLK=64,NQB=SEQ/QB;
constexpr int ATTN_UNIT_ROWS=QB;
__device__ __forceinline__ int crow(int r,int hi){return (r&3)+8*(r>>2)+4*hi;}
#define SBAR() __builtin_amdgcn_sched_barrier(0)
__device__ __forceinline__ void cmask(f32x16&p0,f32x16&p1,int jb,int qrel,int hi){
  const float NEG=-INFINITY; int kb=64*jb+4*hi;
  #pragma unroll
  for(int r=0;r<16;++r){int kv=kb+(r&3)+8*(r>>2); if(kv>qrel)p0[r]=NEG; if(kv+32>qrel)p1[r]=NEG;}
}

constexpr int NSLOT=3, SLOTB=8192;
constexpr int LDS_K=0, LDS_V=NSLOT*SLOTB, LDS_WS=2*NSLOT*SLOTB, LDS_OST=LDS_WS+NW*64*4, LDS_BYTES=LDS_OST+NW*4096, LDS_KM=LDS_BYTES, LDS_BT=LDS_KM+4096, LDS_TOTAL=LDS_BT+1024;
constexpr float C2=0.125f*1.4426950408889634f;
__device__ __forceinline__ void glds16(const void*gsrc,unsigned lds_dst){unsigned keep;
  asm volatile("s_mov_b32 %0, m0\n\ts_mov_b32 m0, %2\n\ts_nop 0\n\tglobal_load_lds_dwordx4 %1, off\n\ts_mov_b32 m0, %0":"=&s"(keep):"v"(gsrc),"s"(lds_dst):"memory");}
__device__ __forceinline__ float max3f(float a,float b,float c){float r;asm("v_max3_f32 %0, %1, %2, %3":"=v"(r):"v"(a),"v"(b),"v"(c));return r;}
__device__ __forceinline__ float max2f(float a,float b){float r;asm("v_max_f32_e32 %0, %1, %2":"=v"(r):"v"(a),"v"(b));return r;}
__device__ __forceinline__ float fadd_s(float a,float b){float r;asm("v_add_f32_e32 %0, %1, %2":"=v"(r):"v"(a),"v"(b));return r;}
__device__ __forceinline__ float fsub_s(float a,float b){float r;asm("v_sub_f32_e32 %0, %1, %2":"=v"(r):"v"(a),"v"(b));return r;}
typedef float f32x2_t __attribute__((ext_vector_type(2))); typedef __bf16 bf16x2_t __attribute__((ext_vector_type(2)));
__device__ __forceinline__ unsigned cvtpk_s(float lo,float hi){f32x2_t v={lo,hi};bf16x2_t b=__builtin_convertvector(v,bf16x2_t);return __builtin_bit_cast(unsigned,b);}
#define WAIT_BAR(N) asm volatile("s_waitcnt vmcnt(" #N ") lgkmcnt(0)\n\ts_barrier":::"memory")

__device__ __forceinline__ void qkt(f32x16&p0,f32x16&p1,const char*Kslot,const bf16x8*qr,const f32x16&negm,int r32,int hi){
  const char*kb=Kslot+hi*1024+r32*16;
  #pragma unroll
  for(int d0=0;d0<4;++d0){
    const bf16x8 b0=*reinterpret_cast<const bf16x8*>(kb+d0*2048);
    const bf16x8 b1=*reinterpret_cast<const bf16x8*>(kb+d0*2048+512);
    if(d0==0){p0=__builtin_amdgcn_mfma_f32_32x32x16_bf16(b0,qr[0],negm,0,0,0);p1=__builtin_amdgcn_mfma_f32_32x32x16_bf16(b1,qr[0],negm,0,0,0);}
    else{p0=__builtin_amdgcn_mfma_f32_32x32x16_bf16(b0,qr[d0],p0,0,0,0);p1=__builtin_amdgcn_mfma_f32_32x32x16_bf16(b1,qr[d0],p1,0,0,0);}}
}
typedef __attribute__((address_space(3))) const char* lds_cptr;
typedef short v4i16_t __attribute__((ext_vector_type(4)));
__device__ __forceinline__ void kload8(bf16x8*kf,lds_cptr kp){
  kf[0]=*(const __attribute__((address_space(3))) bf16x8*)(kp);      kf[1]=*(const __attribute__((address_space(3))) bf16x8*)(kp+512);
  kf[2]=*(const __attribute__((address_space(3))) bf16x8*)(kp+2048); kf[3]=*(const __attribute__((address_space(3))) bf16x8*)(kp+2560);
  kf[4]=*(const __attribute__((address_space(3))) bf16x8*)(kp+4096); kf[5]=*(const __attribute__((address_space(3))) bf16x8*)(kp+4608);
  kf[6]=*(const __attribute__((address_space(3))) bf16x8*)(kp+6144); kf[7]=*(const __attribute__((address_space(3))) bf16x8*)(kp+6656);
}
__device__ __forceinline__ void kload2(bf16x8*kf,lds_cptr kp,int j){ kf[2*j]=*(const __attribute__((address_space(3))) bf16x8*)(kp+j*2048); kf[2*j+1]=*(const __attribute__((address_space(3))) bf16x8*)(kp+j*2048+512); }
__device__ __forceinline__ s16x4 vtr(lds_cptr p){ return __builtin_bit_cast(s16x4,__builtin_amdgcn_ds_read_tr16_b64_v4i16((__attribute__((address_space(3))) v4i16_t*)p)); }
__device__ __forceinline__ float rowmax(const f32x16&p0,const f32x16&p1){
  float a=max3f(p0[0],p0[1],p1[0]),b=max3f(p0[2],p0[3],p1[1]);a=max3f(a,p1[2],p1[3]);
  #pragma unroll
  for(int r=4;r<16;r+=4){a=max3f(a,p0[r],p0[r+1]);b=max3f(b,p0[r+2],p0[r+3]);a=max3f(a,p1[r],p1[r+1]);b=max3f(b,p1[r+2],p1[r+3]);}
  const float m=max2f(a,b);
  auto rr=__builtin_amdgcn_permlane32_swap(__float_as_uint(m),__float_as_uint(m),false,false);
  return max2f(__uint_as_float(rr[0]),__uint_as_float(rr[1]));
}
__device__ __forceinline__ void pv(f32x16*o,int vb,bf16x8 pa0,bf16x8 pa1,bf16x8 pa2,bf16x8 pa3){
  #pragma unroll
  for(int d0=0;d0<2;++d0){s16x4 lo[4],hi[4];
    #pragma unroll
    for(int ks=0;ks<4;++ks){
      asm volatile("ds_read_b64_tr_b16 %0,%1 offset:%c2":"=&v"(lo[ks]):"v"(vb),"i"(d0*4096+ks*1024):"memory");
      asm volatile("ds_read_b64_tr_b16 %0,%1 offset:%c2":"=&v"(hi[ks]):"v"(vb),"i"(d0*4096+ks*1024+512):"memory");}
    asm volatile("s_waitcnt lgkmcnt(0)":::"memory");SBAR();
    #define PK(k) (bf16x8){lo[k][0],lo[k][1],lo[k][2],lo[k][3],hi[k][0],hi[k][1],hi[k][2],hi[k][3]}
    o[d0]=__builtin_amdgcn_mfma_f32_32x32x16_bf16(pa0,PK(0),o[d0],0,0,0);
    o[d0]=__builtin_amdgcn_mfma_f32_32x32x16_bf16(pa1,PK(1),o[d0],0,0,0);
    o[d0]=__builtin_amdgcn_mfma_f32_32x32x16_bf16(pa2,PK(2),o[d0],0,0,0);
    o[d0]=__builtin_amdgcn_mfma_f32_32x32x16_bf16(pa3,PK(3),o[d0],0,0,0);
    #undef PK
  }
}

typedef __attribute__((address_space(3))) const float* lds_cfptr;
__device__ __forceinline__ void cbias(f32x16&p0,f32x16&p1,lds_cfptr bt,int dbase){
  #pragma unroll
  for(int g=0;g<4;++g){
    #pragma unroll
    for(int e=0;e<4;++e){ const int r=4*g+e; const int d0=dbase-((r&3)+8*(r>>2)); const int d1=d0-32;
      p0[r]+=bt[min(max(d0,0),128)]; p1[r]+=bt[min(max(d1,0),128)]; }
    asm volatile("":::"memory"); }
}
#ifndef ATTN_STORE16
#define ATTN_STORE16(p,v) (*(u32x4*)(p)=(v))
#endif
template<int THRL> __device__ __forceinline__ void attn_unit(int b,int h,int qb,const bf16*Q,const bf16*__restrict__ K,const bf16*__restrict__ V,bf16*O,const float*kmean_bh,const float*biast_h,char*shm){
  const int tid=threadIdx.x,lane=tid&63,r32=lane&31,hi=lane>>5; const int wid=__builtin_amdgcn_readfirstlane(tid>>6);
  const long rowbase=(long)b*SEQ; const int q0=qb*QB;
  const bf16*Qw=Q+(rowbase+q0+wid*QBLK)*PQ+h*D;
  const bf16*Kh=K+rowbase*PQ+h*D,*Vh=V+rowbase*PQ+h*D;
  const unsigned lds0=(unsigned)(uintptr_t)shm;
  float*wsf=(float*)(shm+LDS_WS)+wid*64;
  const bf16*ksrc=Kh+(long)lane*PQ+wid*8;
  const bf16*vsrc=Vh+(long)(16*(wid&3)+(lane>>2))*PQ+(wid>>2)*32+(lane&3)*8;
  const unsigned kdst=lds0+LDS_K+wid*1024, vdst=lds0+LDS_V+wid*1024;
  #define DMA_K(t,slot) glds16(ksrc+(long)(t)*KVBLK*PQ,(unsigned)__builtin_amdgcn_readfirstlane(kdst+(slot)))
  #define DMA_V(t,slot) glds16(vsrc+(long)(t)*KVBLK*PQ,(unsigned)__builtin_amdgcn_readfirstlane(vdst+(slot)))
  const int vb0=(int)(lds0+LDS_V)+((lane>>4)&1)*32+(lane&3)*8+(4*hi+((lane&15)>>2))*64;
  const char*Kbase=shm+LDS_K; bf16x8 kf[8];
  const lds_cptr shm3=(lds_cptr)shm; const lds_cptr kp0=shm3+LDS_K+hi*1024+r32*16; const lds_cptr vp0=shm3+LDS_V+((lane>>4)&1)*32+(lane&3)*8+(4*hi+((lane&15)>>2))*64;
  const int NT=(q0+QB)/KVBLK;
  { typedef __attribute__((address_space(3))) float* lds_fptr; typedef float f32x2g __attribute__((ext_vector_type(2)));
    int t_=threadIdx.x; asm volatile("":"+v"(t_));
    const f32x2g kmv=((const f32x2g*)kmean_bh)[t_]; float btv=0.f; if(t_<132)btv=biast_h[t_];
    *(__attribute__((address_space(3))) f32x2g*)((lds_fptr)(shm3+LDS_KM)+2*t_)=kmv; if(t_<132)((lds_fptr)(shm3+LDS_BT))[t_]=btv; }
  DMA_K(0,0);DMA_V(0,0);DMA_K(1,SLOTB);
  bf16x8 qr[4];
  #pragma unroll
  for(int d0=0;d0<4;++d0)qr[d0]=*reinterpret_cast<const bf16x8*>(&Qw[(long)r32*PQ+d0*16+hi*8]);
  float mhat=0.f,l_reg=0.f;f32x16 o[2];o[0]=f32x16{};o[1]=f32x16{};f32x16 negm=f32x16{};asm volatile("":"+v"(negm));
  const int qrel=wid*QBLK+r32; const int qabs=q0+qrel; unsigned selmask=0u;
  const lds_cfptr btL=(lds_cfptr)(shm3+LDS_BT);
  #define SETBASE(t) do{ const int j_=(t)>>2; const bool on_=(j_>=qb)||(((selmask>>j_)&1u)!=0u); const float cbase= on_ ? (((t)>=NT-6)?0.f:bfar) : -1e30f; \
    _Pragma("unroll") for(int r=0;r<16;++r)negm[r]=cbase-mhat; asm volatile("":"+v"(negm)); }while(0)
  #define CMASK(P0,P1,t) do{ if((t)>=NT-6){ cbias(P0,P1,btL,qabs-64*(t)-4*hi); int jb_=(t)-(NT-4); if(jb_>=0)cmask(P0,P1,jb_,qrel,hi);} }while(0)
  bool resc=false;
  #define START(P0,P1) do{ const float rm=rowmax(P0,P1); resc=false; \
    { const float dl=max2f(rm,0.f); mhat=fadd_s(mhat,dl); \
      _Pragma("unroll") for(int r=0;r<16;++r){P0[r]=fsub_s(P0[r],dl);P1[r]=fsub_s(P1[r],dl);} \
      { const float nn_=negm[0]-dl; _Pragma("unroll") for(int r=0;r<16;++r)negm[r]=nn_; } asm volatile("":"+v"(negm)); } \
    _Pragma("unroll") for(int r=0;r<16;++r)P0[r]=__builtin_amdgcn_exp2f(P0[r]); }while(0)
  #define RESC() do{ if(resc){ asm volatile("s_waitcnt lgkmcnt(0)":::"memory"); \
      _Pragma("unroll") for(int d_=0;d_<2;++d_) _Pragma("unroll") for(int r=0;r<16;++r)o[d_][r]*=wsf[crow(r,hi)]; } }while(0)
  f32x16 pA0,pA1,pB0,pB1;
  int sl_prev=0,sl_cur=0,sl_next=SLOTB;
  #define ROT() do{sl_prev=sl_cur;sl_cur=sl_next;sl_next=(sl_next==(NSLOT-1)*SLOTB)?0:sl_next+SLOTB;}while(0)
  DMA_K(2,2*SLOTB);
  WAIT_BAR(3);
  const float bfar=btL[128];
  if(qb<=3) selmask=(1u<<qb)-1u;
  else{ const lds_cfptr kmL=(lds_cfptr)(shm3+LDS_KM); float g0=-INFINITY,g1=-INFINITY,g2=-INFINITY; int i0=0,i1=0,i2=0;
    for(int j=0;j<qb;++j){ float g=0.f;
      #pragma unroll
      for(int d0=0;d0<4;++d0){ const lds_cfptr kp_=kmL+j*64+d0*16+hi*8;
        #pragma unroll
        for(int e=0;e<8;++e) g+=__builtin_bit_cast(float,((unsigned)(unsigned short)qr[d0][e])<<16)*kp_[e]; }
      g+=__shfl_xor(g,32);
      if(g>g0){g2=g1;i2=i1;g1=g0;i1=i0;g0=g;i0=j;} else if(g>g1){g2=g1;i2=i1;g1=g;i1=j;} else if(g>g2){g2=g;i2=j;} }
    selmask=(1u<<i0)|(1u<<i1)|(1u<<i2); }
  SETBASE(0);
  qkt(pA0,pA1,Kbase,qr,negm,r32,hi);asm volatile("s_nop 15\n\ts_nop 7":"+v"(pA0),"+v"(pA1));CMASK(pA0,pA1,0);
  START(pA0,pA1);
  _Pragma("unroll") for(int r=0;r<16;++r)pA1[r]=__builtin_amdgcn_exp2f(pA1[r]);
  WAIT_BAR(0);
  DMA_K(3,0);DMA_V(1,SLOTB);
  ROT();
  kload8(kf,kp0+sl_cur);
  WAIT_BAR(2);
  s16x4 vlo[8],vhi[8]; u32x4 pw0,pw1,pw2,pw3;
  #define PKW(P,B) cvtpk_s(P[B],P[B+1])
  #define PAF(k) __builtin_bit_cast(bf16x8,pw##k)
  #define VFR(i) (bf16x8){vlo[i][0],vlo[i][1],vlo[i][2],vlo[i][3],vhi[i][0],vhi[i][1],vhi[i][2],vhi[i][3]}
  #define PIN(x) asm volatile("":"+v"(x))
  #define MX3(a,b,c) __builtin_fmaxf(__builtin_fmaxf((a),(b)),(c))
  #define GAPA(MF,A0,A1,A2,A3,W0,W1,PW) do{ MF; sacc+=A0; sacc+=A1; sacc+=A2; sacc+=A3; PIN(sacc); W0; W1; PIN(PW); SBAR(); }while(0)
  #define EX(v) __builtin_amdgcn_exp2f(v)
  #define GAPB(MF,X,B) do{ MF; X[B]=EX(X[B]); X[B+1]=EX(X[B+1]); X[B+2]=EX(X[B+2]); X[B+3]=EX(X[B+3]); PIN(X); SBAR(); }while(0)
  #define VRD(i) do{ vlo[i]=vtr(vp_+(((i)>>2)*4096+((i)&3)*1024)); vhi[i]=vtr(vp_+(((i)>>2)*4096+((i)&3)*1024+512)); }while(0)
  #define KRD(G,j) do{ if(G){ kload2(kf,kp0+sl_next,j); SBAR(); } }while(0)
  #define STEP(C0,C1,P0,P1,t,GK,GV,GL) do{ SBAR(); \
    const lds_cptr vp_=vp0+sl_prev; \
    VRD(0); SBAR(); float sacc=(P0[0]+P0[1]); \
    GAPA(C0=__builtin_amdgcn_mfma_f32_32x32x16_bf16(kf[0],qr[0],negm,0,0,0), P0[2],P0[3],P0[4],P0[5],     pw0[0]=PKW(P0,0), pw0[1]=PKW(P0,2), pw0); \
    VRD(4); SBAR(); GAPA(C1=__builtin_amdgcn_mfma_f32_32x32x16_bf16(kf[1],qr[0],negm,0,0,0), P0[6],P0[7],P0[8],P0[9],     pw0[2]=PKW(P0,4), pw0[3]=PKW(P0,6), pw0); \
    VRD(1); SBAR(); GAPA(C0=__builtin_amdgcn_mfma_f32_32x32x16_bf16(kf[2],qr[1],C0,0,0,0),   P0[10],P0[11],P0[12],P0[13], pw1[0]=PKW(P0,8), pw1[1]=PKW(P0,10), pw1); \
    VRD(5); SBAR(); GAPA(C1=__builtin_amdgcn_mfma_f32_32x32x16_bf16(kf[3],qr[1],C1,0,0,0),   P0[14],P0[15],P1[0],P1[1],   pw1[2]=PKW(P0,12),pw1[3]=PKW(P0,14), pw1); \
    VRD(2); SBAR(); GAPA(C0=__builtin_amdgcn_mfma_f32_32x32x16_bf16(kf[4],qr[2],C0,0,0,0),   P1[2],P1[3],P1[4],P1[5],     pw2[0]=PKW(P1,0), pw2[1]=PKW(P1,2), pw2); \
    VRD(6); SBAR(); GAPA(C1=__builtin_amdgcn_mfma_f32_32x32x16_bf16(kf[5],qr[2],C1,0,0,0),   P1[6],P1[7],P1[8],P1[9],     pw2[2]=PKW(P1,4), pw2[3]=PKW(P1,6), pw2); \
    VRD(3); SBAR(); GAPA(C0=__builtin_amdgcn_mfma_f32_32x32x16_bf16(kf[6],qr[3],C0,0,0,0),   P1[10],P1[11],P1[12],P1[13], pw3[0]=PKW(P1,8), pw3[1]=PKW(P1,10), pw3); \
    VRD(7); SBAR(); GAPA(C1=__builtin_amdgcn_mfma_f32_32x32x16_bf16(kf[7],qr[3],C1,0,0,0),   P1[14],P1[15],0.f,0.f,       pw3[2]=PKW(P1,12),pw3[3]=PKW(P1,14), pw3); \
    l_reg+=sacc; \
    if(GK){DMA_K((t)+3,sl_cur);} if(GV){DMA_V((t)+1,sl_next);} \
    CMASK(C0,C1,t); \
    { float a=MX3(C0[0],C0[1],C1[0]),b=MX3(C0[2],C0[3],C1[1]); a=MX3(a,C1[2],C1[3]); \
      _Pragma("unroll") for(int r=4;r<16;r+=4){a=MX3(a,C0[r],C0[r+1]);b=MX3(b,C0[r+2],C0[r+3]);a=MX3(a,C1[r],C1[r+1]);b=MX3(b,C1[r+2],C1[r+3]);} \
      float rm=__builtin_fmaxf(a,b); { auto rr=__builtin_amdgcn_permlane32_swap(__float_as_uint(rm),__float_as_uint(rm),false,false); rm=__builtin_fmaxf(__uint_as_float(rr[0]),__uint_as_float(rr[1])); } \
      resc=false; \
      if(__builtin_expect(__any(rm>(float)THRL),0)){ const float dl=__builtin_fmaxf(rm,0.f); mhat+=dl; \
        _Pragma("unroll") for(int r=0;r<16;++r){C0[r]-=dl;C1[r]-=dl;} \
        { const float nn_=negm[0]-dl; _Pragma("unroll") for(int r=0;r<16;++r)negm[r]=nn_; } asm volatile("":"+v"(negm)); \
        const float f=__builtin_amdgcn_exp2f(-dl); l_reg*=f; if(hi==0)wsf[r32]=f; resc=true; } } \
    SBAR(); \
    GAPB(o[0]=__builtin_amdgcn_mfma_f32_32x32x16_bf16(PAF(0),VFR(0),o[0],0,0,0), C0,0); \
    GAPB(o[1]=__builtin_amdgcn_mfma_f32_32x32x16_bf16(PAF(0),VFR(4),o[1],0,0,0), C0,4); \
    KRD(GL,0); GAPB(o[0]=__builtin_amdgcn_mfma_f32_32x32x16_bf16(PAF(1),VFR(1),o[0],0,0,0), C0,8); \
    KRD(GL,1); GAPB(o[1]=__builtin_amdgcn_mfma_f32_32x32x16_bf16(PAF(1),VFR(5),o[1],0,0,0), C0,12); \
    KRD(GL,2); GAPB(o[0]=__builtin_amdgcn_mfma_f32_32x32x16_bf16(PAF(2),VFR(2),o[0],0,0,0), C1,0); \
    KRD(GL,3); GAPB(o[1]=__builtin_amdgcn_mfma_f32_32x32x16_bf16(PAF(2),VFR(6),o[1],0,0,0), C1,4); \
    GAPB(o[0]=__builtin_amdgcn_mfma_f32_32x32x16_bf16(PAF(3),VFR(3),o[0],0,0,0), C1,8); \
    GAPB(o[1]=__builtin_amdgcn_mfma_f32_32x32x16_bf16(PAF(3),VFR(7),o[1],0,0,0), C1,12); \
    }while(0)
  int t=1;
  #undef CMASK
  #define CMASK(P0,P1,t) do{}while(0)
  for(;t+7<NT;t+=2){
    STEP(pB0,pB1,pA0,pA1,t,true,true,true);     WAIT_BAR(2); RESC(); ROT();
    if(((t+1)&3)==0){SETBASE(t+1);}
    STEP(pA0,pA1,pB0,pB1,t+1,true,true,true);   WAIT_BAR(2); RESC(); ROT();
  }
  #undef CMASK
  #define CMASK(P0,P1,t) do{ if((t)>=NT-6){ cbias(P0,P1,btL,qabs-64*(t)-4*hi); int jb_=(t)-(NT-4); if(jb_>=0)cmask(P0,P1,jb_,qrel,hi);} }while(0)
  #define ENDW(tt) do{ if((tt)+3<NT){WAIT_BAR(2);} else if((tt)+2<NT){WAIT_BAR(1);} else {WAIT_BAR(0);} }while(0)
  for(;t+1<NT;t+=2){
    STEP(pB0,pB1,pA0,pA1,t,(t+3<NT),(t+1<NT),(t+1<NT));       ENDW(t);   RESC(); ROT();
    SETBASE(t+1);
    STEP(pA0,pA1,pB0,pB1,t+1,(t+4<NT),(t+2<NT),(t+2<NT));     ENDW(t+1); RESC(); ROT();
  }
  STEP(pB0,pB1,pA0,pA1,NT-1,false,false,false); RESC();
  { float sacc=pB0[0]+pB0[1]; _Pragma("unroll") for(int r=2;r<16;++r)sacc+=pB0[r]; _Pragma("unroll") for(int r=0;r<16;++r)sacc+=pB1[r]; l_reg+=sacc;
    pw0=(u32x4){PKW(pB0,0),PKW(pB0,2),PKW(pB0,4),PKW(pB0,6)};pw1=(u32x4){PKW(pB0,8),PKW(pB0,10),PKW(pB0,12),PKW(pB0,14)};pw2=(u32x4){PKW(pB1,0),PKW(pB1,2),PKW(pB1,4),PKW(pB1,6)};pw3=(u32x4){PKW(pB1,8),PKW(pB1,10),PKW(pB1,12),PKW(pB1,14)};
    SBAR(); pv(o,vb0+sl_cur,PAF(0),PAF(1),PAF(2),PAF(3)); }
  #undef PKW
  #undef PAF
  #undef VFR
  #undef PIN
  #undef MX3
  #undef GAPA
  #undef GAPB
  #undef EX
  #undef VRD
  #undef KRD
  #undef STEP
  #undef ENDW
  {auto rr=__builtin_amdgcn_permlane32_swap(__float_as_uint(l_reg),__float_as_uint(l_reg),false,false);l_reg=__uint_as_float(rr[0])+__uint_as_float(rr[1]);}
  if(hi==0)wsf[32+r32]=l_reg;asm volatile("s_waitcnt lgkmcnt(0)":::"memory");
  float rli[16];
  #pragma unroll
  for(int r=0;r<16;++r)rli[r]=__builtin_amdgcn_rcpf(wsf[32+crow(r,hi)]);
  bf16*Ow=O+(rowbase+q0+wid*QBLK)*PO+h*D;
  { bf16*stg=(bf16*)(shm+LDS_OST)+wid*2048;
    #pragma unroll
    for(int r=0;r<16;++r){const int orow=crow(r,hi);
      #pragma unroll
      for(int d0=0;d0<2;++d0)stg[orow*64+d0*32+r32]=__float2bfloat16(o[d0][r]*rli[r]);}
    asm volatile("s_waitcnt lgkmcnt(0)":::"memory");
    #pragma unroll
    for(int i=0;i<4;++i){const int row=i*8+(lane>>3),ch=lane&7; const u32x4 v=*(const u32x4*)(stg+row*64+ch*8); ATTN_STORE16(Ow+(long)row*PO+ch*8,v);} }
  asm volatile("s_waitcnt lgkmcnt(0)\n\ts_barrier":::"memory");
  #undef DMA_K
  #undef DMA_V
  #undef CMASK
  #undef START
  #undef RESC
  #undef ROT
  #undef SETBASE
}
constexpr int ATTN_LDS_BYTES=LDS_TOTAL;
struct AttnTensors { const bf16* Q; const bf16* K; const bf16* V; bf16* O; const float* kmean; const float* biast; };
struct AttnUnit { int bh; int qb; };
struct StaticOrder {
  int vcu;
  __device__ __forceinline__ explicit StaticOrder(int grid,int block):vcu((block%8)*(grid/8)+block/8){}
  __device__ __forceinline__ bool next(int i,AttnUnit&u)const{ if(i>=4)return false; const int s=vcu&3; u.bh=vcu>>2; u.qb=(i==0)?15-s:(i==1)?8+s:(i==2)?7-s:s; return true; }
  __device__ __forceinline__ void a_ready(const AttnUnit&)const{}
  __device__ __forceinline__ void done(const AttnUnit&)const{}
};
template<class Sched,int THRL=8> __device__ __forceinline__ void attn_phase(char*lds,const AttnTensors&T,const Sched&S){
  AttnUnit u;
  for(int i=0;S.next(i,u);++i){ S.a_ready(u); attn_unit<THRL>(u.bh/NHEAD,u.bh%NHEAD,u.qb,T.Q,T.K,T.V,T.O,T.kmean+(size_t)u.bh*1024,T.biast+(u.bh%NHEAD)*132,lds); S.done(u); }
}
#undef SBAR
#undef WAIT_BAR
}
typedef short bf16x8v __attribute__((ext_vector_type(8)));
typedef float f32x16v __attribute__((ext_vector_type(16)));
typedef float f32x2v_ __attribute__((ext_vector_type(2)));
typedef unsigned u32x2v_ __attribute__((ext_vector_type(2)));
__device__ __forceinline__ int crow_(int r, int hi) { return (r & 3) + 8 * (r >> 2) + 4 * hi; }
__device__ __forceinline__ unsigned cvtpk(float lo, float hi) { typedef __bf16 bf2 __attribute__((ext_vector_type(2))); f32x2v_ v = {lo, hi}; bf2 b = __builtin_convertvector(v, bf2); return __builtin_bit_cast(unsigned, b); }
__device__ __forceinline__ bf16x8v pack8(const float (&x)[8]) { v4u w; w.x = cvtpk(x[0], x[1]); w.y = cvtpk(x[2], x[3]); w.z = cvtpk(x[4], x[5]); w.w = cvtpk(x[6], x[7]); return __builtin_bit_cast(bf16x8v, w); }
__device__ __forceinline__ void unpack8(v4u w, float (&x)[8]) {
#pragma unroll
    for (int e = 0; e < 4; ++e) { x[2 * e] = bflo(w[e]); x[2 * e + 1] = bfhi(w[e]); } }
#define WG_SYNC() __syncthreads()

__device__ __forceinline__ void kmean_unit(LAS unsigned char* shm, int b, int blk, const bf16* PROJ, float* KMEAN, int tid, int wave, int lane) {
    float acc[8];
#pragma unroll
    for (int e = 0; e < 8; ++e) acc[e] = 0.f;
    const bf16* base = PROJ + ((size_t)b * SEQ + blk * 256) * LDP + C_MK + 8 * lane;
#pragma unroll 8
    for (int i = 0; i < 32; ++i) { const v4u w = *(const GAS v4u*)(base + (size_t)(wave + 8 * i) * LDP); float x[8]; unpack8(w, x);
#pragma unroll
        for (int e = 0; e < 8; ++e) acc[e] += x[e]; }
    LAS float* red = (LAS float*)shm;
#pragma unroll
    for (int e = 0; e < 8; ++e) red[wave * 512 + lane * 8 + e] = acc[e];
    WG_SYNC();
    float s = 0.f;
#pragma unroll
    for (int w = 0; w < 8; ++w) s += red[w * 512 + tid];
    KMEAN[(((size_t)b * 8 + (tid >> 6)) * 16 + blk) * 64 + (tid & 63)] = s * (1.0f / 256.0f);
    WG_SYNC();
}

constexpr int LRU_XCF = 0, LRU_AA = 32768, LRU_UU = 65536, LRU_XCB = 98304, LRU_XCB_LD = 264;
__device__ __forceinline__ float fast_sigmoid(float x) { return __builtin_amdgcn_rcpf(1.0f + __expf(-x)); }
__device__ __forceinline__ void lru_pass(LAS unsigned char* shm, int b, int c, const bf16* PROJ, const bf16* WaT, const bf16* WxT, const float* cw, const float* cb,
                                         const float* ba, const float* bx, const float* lam, float* SUMM, bf16* HLOC, bf16* PCUM, int tid, int wave, int lane) {
    LAS float* XCF = (LAS float*)(shm + LRU_XCF); LAS float* AA = (LAS float*)(shm + LRU_AA); LAS float* UU = (LAS float*)(shm + LRU_UU); LAS bf16* XCB = (LAS bf16*)(shm + LRU_XCB);
    const int r32 = lane & 31, hi = lane >> 5;
    const int g = wave >> 1, nt = wave & 1, ch = g * 64 + 32 * nt + r32;
    bf16x8v BfA[4], BfX[4];
#pragma unroll
    for (int ks = 0; ks < 4; ++ks) { BfA[ks] = *(const GAS bf16x8v*)(WaT + (size_t)g * 4096 + (32 * nt + r32) * 64 + 16 * ks + 8 * hi);
                                     BfX[ks] = *(const GAS bf16x8v*)(WxT + (size_t)g * 4096 + (32 * nt + r32) * 64 + 16 * ks + 8 * hi); }
    const float bias_a = ba[ch], bias_x = bx[ch], k8 = 8.0f * softplusf_(-lam[ch]);
    float hst = 0.f, aprod = 1.f;
    const int tt = tid >> 4, c0 = (tid & 15) * 16;
    for (int sb = 0; sb < 4; ++sb) {
        const int t0 = c * 128 + sb * 32; const size_t row0 = (size_t)b * SEQ + t0;
        { float xc[16];
#pragma unroll
          for (int e = 0; e < 16; ++e) xc[e] = cb[c0 + e];
#pragma unroll
          for (int j = 0; j < 4; ++j) { const int t = t0 + tt - 3 + j;
              if (t >= 0) { const bf16* xp = PROJ + ((size_t)b * SEQ + t) * LDP + C_LX + c0; const v4u w0 = *(const GAS v4u*)xp, w1 = *(const GAS v4u*)(xp + 8);
                  float x0[8], x1[8]; unpack8(w0, x0); unpack8(w1, x1);
#pragma unroll
                  for (int e = 0; e < 8; ++e) { xc[e] += cw[j * 256 + c0 + e] * x0[e]; xc[8 + e] += cw[j * 256 + c0 + 8 + e] * x1[e]; } } }
#pragma unroll
          for (int q4 = 0; q4 < 4; ++q4) *(LAS f32x4*)(XCF + tt * 256 + c0 + 4 * q4) = (f32x4){xc[4 * q4], xc[4 * q4 + 1], xc[4 * q4 + 2], xc[4 * q4 + 3]};
          float a8[8], b8[8];
#pragma unroll
          for (int e = 0; e < 8; ++e) { a8[e] = xc[e]; b8[e] = xc[8 + e]; }
          *(LAS bf16x8v*)(XCB + tt * LRU_XCB_LD + c0) = pack8(a8); *(LAS bf16x8v*)(XCB + tt * LRU_XCB_LD + c0 + 8) = pack8(b8); }
        WG_SYNC();
        { f32x16v accr = {}, acci = {};
#pragma unroll
          for (int ks = 0; ks < 4; ++ks) { const bf16x8v Af = *(const LAS bf16x8v*)(XCB + r32 * LRU_XCB_LD + g * 64 + 16 * ks + 8 * hi);
              accr = __builtin_amdgcn_mfma_f32_32x32x16_bf16(Af, BfA[ks], accr, 0, 0, 0); acci = __builtin_amdgcn_mfma_f32_32x32x16_bf16(Af, BfX[ks], acci, 0, 0, 0); }
#pragma unroll
          for (int r = 0; r < 16; ++r) { const int tok = crow_(r, hi);
              const float rr = fast_sigmoid(accr[r] + bias_a), ig = fast_sigmoid(acci[r] + bias_x);
              const float a = __expf(-k8 * rr); float mult = sqrtf(fmaxf(1.0f - a * a, 0.f)); if (t0 + tok == 0) mult = 1.0f;
              AA[tok * 256 + ch] = a; UU[tok * 256 + ch] = mult * (ig * XCF[tok * 256 + ch]); } }
        WG_SYNC();
        if (tid < 256) {
#pragma unroll 8
            for (int i = 0; i < 32; ++i) { const float a = AA[i * 256 + tid], u = UU[i * 256 + tid]; hst = a * hst + u; aprod *= a; UU[i * 256 + tid] = hst; AA[i * 256 + tid] = aprod; } }
        WG_SYNC();
        { float h16[16], p16[16];
#pragma unroll
          for (int q4 = 0; q4 < 4; ++q4) { const f32x4 hv = *(const LAS f32x4*)(UU + tt * 256 + c0 + 4 * q4), pv = *(const LAS f32x4*)(AA + tt * 256 + c0 + 4 * q4);
#pragma unroll
              for (int e = 0; e < 4; ++e) { h16[4 * q4 + e] = hv[e]; p16[4 * q4 + e] = pv[e]; } }
          float t8[8];
#pragma unroll
          for (int hf = 0; hf < 2; ++hf) {
#pragma unroll
              for (int e = 0; e < 8; ++e) t8[e] = h16[8 * hf + e];
              *(GAS bf16x8v*)(HLOC + (row0 + tt) * 256 + c0 + 8 * hf) = pack8(t8);
#pragma unroll
              for (int e = 0; e < 8; ++e) t8[e] = p16[8 * hf + e];
              *(GAS bf16x8v*)(PCUM + (row0 + tt) * 256 + c0 + 8 * hf) = pack8(t8); } }
    }
    if (tid < 256) { float* sp = SUMM + ((size_t)(b * 32 + c) * 2) * 256; sp[tid] = aprod; sp[256 + tid] = hst; }
    WG_SYNC();
}
__device__ __forceinline__ void lru_final(LAS unsigned char* shm, int b, int c, const bf16* PROJ, const float* SUMM, const bf16* HLOC, const bf16* PCUM, bf16* MIX, int tid) {
    LAS float* carry = (LAS float*)shm;
    if (tid < 256) { float h = 0.f;
#pragma unroll 4
        for (int cc = 0; cc < c; ++cc) { const float* sp = SUMM + ((size_t)(b * 32 + cc) * 2) * 256; h = sp[tid] * h + sp[256 + tid]; }
        carry[tid] = h; }
    WG_SYNC();
#pragma unroll 2
    for (int it = 0; it < 8; ++it) { const int item = it * 512 + tid, tok = item >> 5, c0 = (item & 31) * 8; const size_t row = (size_t)b * SEQ + c * 128 + tok;
        const v4u hw = *(const GAS v4u*)(HLOC + row * 256 + c0), pw = *(const GAS v4u*)(PCUM + row * 256 + c0), gw = *(const GAS v4u*)(PROJ + row * LDP + C_LG + c0);
        const f32x4 ca = *(const LAS f32x4*)(carry + c0), cb2 = *(const LAS f32x4*)(carry + c0 + 4);
        float hl[8], pc[8], gt[8], y[8]; unpack8(hw, hl); unpack8(pw, pc); unpack8(gw, gt);
#pragma unroll
        for (int e = 0; e < 8; ++e) { const float cr = e < 4 ? ca[e] : cb2[e - 4]; const float gate = gt[e]; const float u = 0.7978845608028654f * (gate + 0.044715f * gate * gate * gate);
            y[e] = (hl[e] + pc[e] * cr) * gate * __builtin_amdgcn_rcpf(1.0f + __expf(-2.0f * u)); }
        *(GAS bf16x8v*)(MIX + row * DM + c0) = pack8(y); }
    WG_SYNC();
}

constexpr int GLA_PW = 14336, GLA_VT = 0, GLA_VT_LD = 72, GLA_KW = 9216, GLA_KW_LD = 40, GLA_DEC = 8 * GLA_PW;
constexpr int GLA_SUM = 2112;
template <bool FINAL>
__device__ __forceinline__ void gla_unit(LAS unsigned char* shm, int b, int h, int grp, const bf16* PROJ, const float* gb, const float* gn, float* GSUM, bf16* MIX, int tid, int wave, int lane) {
    const int r32 = lane & 31, hi = lane >> 5;
    LAS unsigned char* pw = shm + wave * GLA_PW;
    LAS float* CUM = (LAS float*)pw; LAS bf16* VT = (LAS bf16*)(pw + GLA_VT); LAS bf16* KW = (LAS bf16*)(pw + GLA_KW); LAS float* DEC = (LAS float*)(shm + GLA_DEC);
    const size_t R0 = (size_t)b * SEQ + grp * 512 + wave * 64;
#pragma unroll
    for (int tt = 0; tt < 2; ++tt)
#pragma unroll
        for (int ks = 0; ks < 2; ++ks) { const int tok = 32 * tt + r32, d0 = 16 * ks + 8 * hi;
            const v4u w = *(const GAS v4u*)(PROJ + (R0 + tok) * LDP + C_GZ + h * 32 + d0); float z[8]; unpack8(w, z);
            const f32x4 g0 = *(const GAS f32x4*)(gb + h * 32 + d0), g1 = *(const GAS f32x4*)(gb + h * 32 + d0 + 4);
            float la[8];
#pragma unroll
            for (int e = 0; e < 8; ++e) { const float zz = z[e] + (e < 4 ? g0[e] : g1[e - 4]); la[e] = -softplusf_(-zz) * (1.0f / 16.0f); }
            *(LAS f32x4*)(CUM + tok * 32 + d0) = (f32x4){la[0], la[1], la[2], la[3]}; *(LAS f32x4*)(CUM + tok * 32 + d0 + 4) = (f32x4){la[4], la[5], la[6], la[7]}; }
    LDS_WAIT(); asm volatile("" ::: "memory");
    float lastd;
    { float v[32];
#pragma unroll
      for (int i = 0; i < 32; ++i) v[i] = CUM[(32 * hi + i) * 32 + r32];
#pragma unroll
      for (int i = 1; i < 32; ++i) v[i] += v[i - 1];
      const float tot0 = __shfl(v[31], r32);
      if (hi) {
#pragma unroll
          for (int i = 0; i < 32; ++i) v[i] += tot0; }
      lastd = __shfl(v[31], 32 + r32);
#pragma unroll
      for (int i = 0; i < 32; ++i) CUM[(32 * hi + i) * 32 + r32] = v[i]; }
    LDS_WAIT(); asm volatile("" ::: "memory");
    const float decay = __expf(lastd);
    bf16x8v qdB[2][2], kdA[2][2];
#pragma unroll
    for (int tt = 0; tt < 2; ++tt)
#pragma unroll
        for (int ks = 0; ks < 2; ++ks) { const int tok = 32 * tt + r32, d0 = 16 * ks + 8 * hi;
            const f32x4 c0 = *(const LAS f32x4*)(CUM + tok * 32 + d0), c1 = *(const LAS f32x4*)(CUM + tok * 32 + d0 + 4);
            const f32x4 l0 = *(const LAS f32x4*)(CUM + 63 * 32 + d0), l1 = *(const LAS f32x4*)(CUM + 63 * 32 + d0 + 4);
            const v4u wq = *(const GAS v4u*)(PROJ + (R0 + tok) * LDP + C_GQ + h * 32 + d0), wk = *(const GAS v4u*)(PROJ + (R0 + tok) * LDP + C_GK + h * 32 + d0);
            float q[8], k[8], qd[8], kd[8], kw[8]; unpack8(wq, q); unpack8(wk, k);
#pragma unroll
            for (int e = 0; e < 8; ++e) { const float cu = e < 4 ? c0[e] : c1[e - 4], la = e < 4 ? l0[e] : l1[e - 4];
                qd[e] = q[e] * __expf(cu); kd[e] = k[e] * __expf(-cu); kw[e] = k[e] * __expf(la - cu); }
            qdB[tt][ks] = pack8(qd); kdA[tt][ks] = pack8(kd);
            *(LAS bf16x8v*)(KW + tok * GLA_KW_LD + d0) = pack8(kw); }
    LDS_WAIT(); asm volatile("" ::: "memory");
#pragma unroll
    for (int i = 0; i < 8; ++i) { const int p = i * 64 + lane, tok = p >> 3, ch = p & 7;
        const v4u w = *(const GAS v4u*)(PROJ + (R0 + tok) * LDP + C_GV + h * 64 + ch * 8); *(LAS v4u*)(VT + tok * GLA_VT_LD + ch * 8) = w; }
    LDS_WAIT(); asm volatile("" ::: "memory");
    bf16x8v vtA[2][4];
#pragma unroll
    for (int mv = 0; mv < 2; ++mv)
#pragma unroll
        for (int kk = 0; kk < 4; ++kk) { bf16x8v f;
#pragma unroll
            for (int j = 0; j < 8; ++j) f[j] = (short)VT[(16 * kk + 8 * (j >> 2) + 4 * hi + (j & 3)) * GLA_VT_LD + 32 * mv + r32];
            vtA[mv][kk] = f; }
    f32x16v kvT[2] = {{}, {}};
#pragma unroll
    for (int kk = 0; kk < 4; ++kk) { bf16x8v f;
#pragma unroll
        for (int j = 0; j < 8; ++j) f[j] = (short)KW[(16 * kk + 8 * (j >> 2) + 4 * hi + (j & 3)) * GLA_KW_LD + r32];
        kvT[0] = __builtin_amdgcn_mfma_f32_32x32x16_bf16(vtA[0][kk], f, kvT[0], 0, 0, 0); kvT[1] = __builtin_amdgcn_mfma_f32_32x32x16_bf16(vtA[1][kk], f, kvT[1], 0, 0, 0); }
    LDS_WAIT(); asm volatile("" ::: "memory");
    { LAS float* KV = (LAS float*)pw;
#pragma unroll
      for (int mv = 0; mv < 2; ++mv)
#pragma unroll
          for (int r = 0; r < 16; ++r) KV[(mv * 16 + r) * 64 + lane] = kvT[mv][r];
      DEC[wave * 64 + lane] = decay; }
    f32x16v oT[2][2] = {{{}, {}}, {{}, {}}};
    if (FINAL) {
#pragma unroll
        for (int mt = 0; mt < 2; ++mt)
#pragma unroll
            for (int nt = 0; nt < 2; ++nt) {
                if (mt == 1 && nt == 0) continue;
                f32x16v at = {};
#pragma unroll
                for (int ks = 0; ks < 2; ++ks) at = __builtin_amdgcn_mfma_f32_32x32x16_bf16(kdA[mt][ks], qdB[nt][ks], at, 0, 0, 0);
                if (mt == nt) {
#pragma unroll
                    for (int r = 0; r < 16; ++r) if (crow_(r, hi) > r32) at[r] = 0.f; }
#pragma unroll
                for (int s = 0; s < 2; ++s) { float x[8];
#pragma unroll
                    for (int j = 0; j < 8; ++j) x[j] = at[8 * s + j];
                    const bf16x8v bfr = pack8(x);
                    oT[0][nt] = __builtin_amdgcn_mfma_f32_32x32x16_bf16(vtA[0][2 * mt + s], bfr, oT[0][nt], 0, 0, 0);
                    oT[1][nt] = __builtin_amdgcn_mfma_f32_32x32x16_bf16(vtA[1][2 * mt + s], bfr, oT[1][nt], 0, 0, 0); } }
    }
    float S[32];
#pragma unroll
    for (int i = 0; i < 32; ++i) S[i] = 0.f;
    if (FINAL) { const float* sb0 = GSUM + (size_t)((b * 4 + h) * 8) * GLA_SUM; float wg[7];
#pragma unroll
        for (int gq = 0; gq < 7; ++gq) { const int gc = gq < grp ? gq : 0; const float d = sb0[(size_t)gc * GLA_SUM + 2048 + lane]; wg[gq] = gq < grp ? d : 1.0f; }
        { float run = 1.0f;
#pragma unroll
          for (int gq = 6; gq >= 0; --gq) { const float d = wg[gq]; wg[gq] = gq < grp ? run : 0.f; run *= d; } }
#pragma unroll
        for (int ib = 0; ib < 4; ++ib) {
#pragma unroll
            for (int gq = 0; gq < 7; ++gq) { const int gc = gq < grp ? gq : 0;
#pragma unroll
                for (int i = 0; i < 8; ++i) S[ib * 8 + i] += wg[gq] * sb0[(size_t)gc * GLA_SUM + (ib * 8 + i) * 64 + lane]; }
            asm volatile("" ::: "memory"); } }
    WG_SYNC();
    float dprod = 1.0f;
    const int nfold = FINAL ? wave : 8;
    if (FINAL || wave == 7) {
        for (int n = 0; n < nfold; ++n) { const LAS float* KVn = (const LAS float*)(shm + n * GLA_PW); const float dn = DEC[n * 64 + lane]; dprod *= dn;
#pragma unroll
            for (int i = 0; i < 32; ++i) S[i] = dn * S[i] + KVn[i * 64 + lane]; } }
    if (!FINAL) {
        if (wave == 7) { float* sp = GSUM + (size_t)((b * 4 + h) * 8 + grp) * GLA_SUM;
#pragma unroll
            for (int i = 0; i < 32; ++i) sp[i * 64 + lane] = S[i];
            sp[2048 + lane] = dprod; }
        WG_SYNC();
        return;
    }
    WG_SYNC();
    { LAS bf16* ST = KW;
#pragma unroll
      for (int mv = 0; mv < 2; ++mv)
#pragma unroll
          for (int r = 0; r < 16; ++r) ST[(32 * mv + crow_(r, hi)) * GLA_KW_LD + r32] = (bf16)f2bf(S[mv * 16 + r]);
      LDS_WAIT(); asm volatile("" ::: "memory");
#pragma unroll
      for (int mv = 0; mv < 2; ++mv)
#pragma unroll
          for (int ks = 0; ks < 2; ++ks) { const bf16x8v sa = *(const LAS bf16x8v*)(ST + (32 * mv + r32) * GLA_KW_LD + 16 * ks + 8 * hi);
              oT[mv][0] = __builtin_amdgcn_mfma_f32_32x32x16_bf16(sa, qdB[0][ks], oT[mv][0], 0, 0, 0); oT[mv][1] = __builtin_amdgcn_mfma_f32_32x32x16_bf16(sa, qdB[1][ks], oT[mv][1], 0, 0, 0); } }
#pragma unroll
    for (int nt = 0; nt < 2; ++nt) { float ss = 0.f;
#pragma unroll
        for (int mv = 0; mv < 2; ++mv)
#pragma unroll
            for (int r = 0; r < 16; ++r) ss += oT[mv][nt][r] * oT[mv][nt][r];
        ss += __shfl_xor(ss, 32);
        const float rstd = 1.0f / sqrtf(ss * (1.0f / 64.0f) + RMS_EPS);
        const size_t row = R0 + 32 * nt + r32;
#pragma unroll
        for (int mv = 0; mv < 2; ++mv)
#pragma unroll
            for (int rg = 0; rg < 4; ++rg) { const int v0 = 32 * mv + 8 * rg + 4 * hi;
                const u32x2v_ gw = *(const GAS u32x2v_*)(PROJ + row * LDP + C_GO + h * 64 + v0); const f32x4 gg = *(const GAS f32x4*)(gn + h * 64 + v0);
                const float go[4] = {bflo(gw.x), bfhi(gw.x), bflo(gw.y), bfhi(gw.y)}; float y[4];
#pragma unroll
                for (int e = 0; e < 4; ++e) y[e] = oT[mv][nt][4 * rg + e] * rstd * gg[e] * (go[e] / (1.0f + __expf(-go[e])));
                u32x2v_ ow; ow.x = cvtpk(y[0], y[1]); ow.y = cvtpk(y[2], y[3]);
                *(GAS u32x2v_*)(MIX + row * DM + 256 + h * 64 + v0) = ow; } }
    WG_SYNC();
}

#define NAIVE_SETUP \
    const int tid = threadIdx.x; const int G = gridDim.x, gt = blockIdx.x * 256 + tid, NGT = G * 256; unsigned char* ws = args.ws; \
    bf16* PROJ = (bf16*)(ws + WS_PROJ); bf16* MIX = (bf16*)(ws + WS_MIX); float* Y = (float*)(ws + WS_Y); \
    float* KMEAN = (float*)(ws + WS_KMEAN); float* BIAST = (float*)(ws + WS_BIAS); \
    float* XC = Y; float* AA = Y + (size_t)M * 256; float* UU = Y + (size_t)2 * M * 256; float* OGLA = Y + (size_t)3 * M * 256; \
    (void)tid; (void)PROJ; (void)MIX; (void)KMEAN; (void)BIAST; (void)XC; (void)AA; (void)UU; (void)OGLA;
__global__ void __launch_bounds__(256) naive_a1(Args args, int l, int nf) { NAIVE_SETUP
            if (nf & 1) for (int i = gt; i < BATCH * 8 * 16 * 64; i += NGT) { const int d = i & 63, blk = (i >> 6) & 15, h = (i >> 10) & 7, b = i >> 13;
                const bf16* p = PROJ + ((size_t)b * SEQ + blk * 256) * LDP + C_MK + h * 64 + d; float s = 0.f;
                for (int r = 0; r < 256; ++r) s += bf2f(p[(size_t)r * LDP]);
                KMEAN[i] = s * (1.0f / 256.0f); }
            if (nf & 2) { const float* cw = args.in[7] + (size_t)l * 4 * 256; const float* cb = args.in[8] + (size_t)l * 256;
              for (size_t i = gt; i < (size_t)M * 256; i += NGT) { const int c = (int)(i & 255); const size_t row = i >> 8; const int t = (int)(row % SEQ);
                float s = cb[c];
#pragma unroll
                for (int j = 0; j < 4; ++j) { const int tt = t - 3 + j; if (tt >= 0) s += cw[j * 256 + c] * bf2f(PROJ[(row - 3 + j) * LDP + C_LX + c]); }
                XC[i] = s; } }
            if (nf & 4) { const float* gb = args.in[15] + (size_t)l * 128;
              for (int i = gt; i < BATCH * 4 * 64; i += NGT) { const int v = i & 63, h = (i >> 6) & 3, b = i >> 8;
                float Sd[32], gbv[32];
#pragma unroll
                for (int d = 0; d < 32; ++d) { Sd[d] = 0.f; gbv[d] = gb[h * 32 + d]; }
                for (int t = 0; t < SEQ; ++t) { const size_t row = (size_t)b * SEQ + t; const bf16* pr = PROJ + row * LDP;
                    const float vv = bf2f(pr[C_GV + h * 64 + v]); float o = 0.f;
                    const v4u* qp = (const v4u*)(pr + C_GQ + h * 32); const v4u* kp = (const v4u*)(pr + C_GK + h * 32); const v4u* zp = (const v4u*)(pr + C_GZ + h * 32);
#pragma unroll
                    for (int c4 = 0; c4 < 4; ++c4) { const v4u qq = qp[c4], kk = kp[c4], zz = zp[c4];
#pragma unroll
                        for (int e = 0; e < 4; ++e) {
#pragma unroll
                            for (int hl = 0; hl < 2; ++hl) { const int d = c4 * 8 + e * 2 + hl;
                                const float qf = hl ? bfhi(qq[e]) : bflo(qq[e]), kf = hl ? bfhi(kk[e]) : bflo(kk[e]), zf = (hl ? bfhi(zz[e]) : bflo(zz[e])) + gbv[d];
                                const float la = -softplusf_(-zf) * (1.0f / 16.0f); const float al = __expf(la);
                                Sd[d] = al * Sd[d] + kf * vv; o += qf * Sd[d]; } } }
                    OGLA[row * 256 + h * 64 + v] = o; } } }
}
__global__ void __launch_bounds__(256) naive_a2(Args args, int l) { NAIVE_SETUP
            const float* wa = args.in[9] + (size_t)l * 4 * 64 * 64; const float* ba = args.in[10] + (size_t)l * 256;
            const float* wx = args.in[11] + (size_t)l * 4 * 64 * 64; const float* bx = args.in[12] + (size_t)l * 256; const float* lam = args.in[13] + (size_t)l * 256;
            for (size_t i = gt; i < (size_t)M * 256; i += NGT) { const int c = (int)(i & 255), g = c >> 6, j = c & 63; const size_t row = i >> 8; const int t = (int)(row % SEQ);
                const float* xr = XC + row * 256 + g * 64; float sr = ba[c], si = bx[c];
                for (int k = 0; k < 64; ++k) { const float xv = xr[k]; sr += xv * wa[(g * 64 + k) * 64 + j]; si += xv * wx[(g * 64 + k) * 64 + j]; }
                const float r = sigmoidf_(sr), ig = sigmoidf_(si);
                const float log_a = -8.0f * r * softplusf_(-lam[c]);
                const float a = __expf(log_a); float mult = sqrtf(-expm1f(2.0f * log_a)); if (t == 0) mult = 1.0f;
                AA[i] = a; UU[i] = mult * (ig * XC[i]); }
}
__global__ void __launch_bounds__(256) naive_c1(Args args, int l, int nf) { NAIVE_SETUP
            if (nf & 2) for (int i = gt; i < BATCH * 256; i += NGT) { const int c = i & 255, b = i >> 8; float h = 0.f;
                for (int t = 0; t < SEQ; ++t) { const size_t row = (size_t)b * SEQ + t; h = AA[row * 256 + c] * h + UU[row * 256 + c];
                    const float gate = bf2f(PROJ[row * LDP + C_LG + c]); MIX[row * DM + c] = (bf16)f2bf(h * gelu_tanh(gate)); } }
            if (nf & 4) { const float* gn = args.in[16] + (size_t)l * 256;
              for (size_t i = gt; i < (size_t)M * 4; i += NGT) { const int h = (int)(i & 3); const size_t row = i >> 2; const float* o = OGLA + row * 256 + h * 64; float ss = 0.f;
                for (int v = 0; v < 64; ++v) ss += o[v] * o[v];
                const float rs = 1.0f / sqrtf(ss * (1.0f / 64.0f) + RMS_EPS);
                for (int v = 0; v < 64; ++v) { const float go = bf2f(PROJ[row * LDP + C_GO + h * 64 + v]); MIX[row * DM + 256 + h * 64 + v] = (bf16)f2bf(o[v] * rs * gn[h * 64 + v] * (go * sigmoidf_(go))); } } }

}
__global__ void __launch_bounds__(256) naive_c2(Args args, int l) { NAIVE_SETUP
            for (int i = gt; i < BATCH * 8 * SEQ; i += NGT) { const int q = i % SEQ, h = (i / SEQ) & 7, b = i / (SEQ * 8);
                const size_t row = (size_t)b * SEQ + q; float qv[64];
                { const v4u* qp = (const v4u*)(PROJ + row * LDP + C_MQ + h * 64);
#pragma unroll
                  for (int c8 = 0; c8 < 8; ++c8) { const v4u w = qp[c8];
#pragma unroll
                      for (int e = 0; e < 4; ++e) { qv[c8 * 8 + e * 2] = bflo(w[e]); qv[c8 * 8 + e * 2 + 1] = bfhi(w[e]); } } }
                const int nb = q >> 8; unsigned selmask;
                if (nb <= 3) selmask = (1u << nb) - 1u;
                else { float g0 = -INFINITY, g1 = -INFINITY, g2 = -INFINITY; int i0 = 0, i1 = 0, i2 = 0;
                    for (int j = 0; j < nb; ++j) { const float* km = KMEAN + (((size_t)b * 8 + h) * 16 + j) * 64; float gsum = 0.f;
#pragma unroll
                        for (int d = 0; d < 64; ++d) gsum += qv[d] * km[d];
                        if (gsum > g0) { g2 = g1; i2 = i1; g1 = g0; i1 = i0; g0 = gsum; i0 = j; } else if (gsum > g1) { g2 = g1; i2 = i1; g1 = gsum; i1 = j; } else if (gsum > g2) { g2 = gsum; i2 = j; } }
                    selmask = (1u << i0) | (1u << i1) | (1u << i2); }
                float mx = -1e30f, lsum = 0.f, o[64];
#pragma unroll
                for (int d = 0; d < 64; ++d) o[d] = 0.f;
                const float* bt = BIAST + h * 132;
                for (int j = 0; j <= nb; ++j) { if (j < nb && !((selmask >> j) & 1u)) continue;
                    const int kend = (j == nb) ? (q & 255) : 255;
                    for (int kk = 0; kk <= kend; ++kk) { const int kpos = j * 256 + kk; const bf16* kr = PROJ + ((size_t)b * SEQ + kpos) * LDP;
                        const v4u* kp = (const v4u*)(kr + C_MK + h * 64); float s = 0.f;
#pragma unroll
                        for (int c8 = 0; c8 < 8; ++c8) { const v4u w = kp[c8];
#pragma unroll
                            for (int e = 0; e < 4; ++e) s += qv[c8 * 8 + e * 2] * bflo(w[e]) + qv[c8 * 8 + e * 2 + 1] * bfhi(w[e]); }
                        const int dist = q - kpos; s += bt[dist < 128 ? dist : 128];
                        if (s > mx) { const float sc = __builtin_amdgcn_exp2f(mx - s); lsum *= sc;
#pragma unroll
                            for (int d = 0; d < 64; ++d) o[d] *= sc;
                            mx = s; }
                        const float p = __builtin_amdgcn_exp2f(s - mx); lsum += p;
                        const v4u* vp = (const v4u*)(kr + C_MV + h * 64);
#pragma unroll
                        for (int c8 = 0; c8 < 8; ++c8) { const v4u w = vp[c8];
#pragma unroll
                            for (int e = 0; e < 4; ++e) { o[c8 * 8 + e * 2] += p * bflo(w[e]); o[c8 * 8 + e * 2 + 1] += p * bfhi(w[e]); } } } }
                const float inv = 1.0f / lsum; v4u* op = (v4u*)(MIX + row * DM + 512 + h * 64);
#pragma unroll
                for (int c8 = 0; c8 < 8; ++c8) { v4u w;
#pragma unroll
                    for (int e = 0; e < 4; ++e) w[e] = pk2(o[c8 * 8 + e * 2] * inv, o[c8 * 8 + e * 2 + 1] * inv);
                    op[c8] = w; } }
}

typedef const __attribute__((address_space(4))) Args CArgs;
struct Ctx { CArgs* ap; XcdBarrier bar; LAS unsigned char* ldsp; unsigned char* lds; };
#define IN(k) (lo <= (k) && (k) < hi)
template <int l> __device__ __forceinline__ void layer_body(const Ctx& C) {
    CArgs* ap = C.ap; const XcdBarrier bar = C.bar; LAS unsigned char* ldsp = C.ldsp; unsigned char* lds = C.lds; const int G = gridDim.x, NGW = G * NWAVES, NGT = G * NTHR; (void)NGT; (void)NGW;
    unsigned char* ws = ap->ws; const int lo = ap->ph_lo, hi = ap->ph_hi, flags = ap->flags & EXP_MASK;
    const float* x_in = ap->in[0]; float* xres = ap->out;
    bf16* XN = (bf16*)(ws + WS_XN); bf16* PROJ = (bf16*)(ws + WS_PROJ); bf16* HFF = (bf16*)(ws + WS_PROJ); bf16* MIX = (bf16*)(ws + WS_MIX); float* Y = (float*)(ws + WS_Y);
    float* KMEAN = (float*)(ws + WS_KMEAN); float* BIAST = (float*)(ws + WS_BIAS); float* LRUSUM = (float*)(ws + WS_LRUSUM); float* GLASUM = (float*)(ws + WS_GLASUM);
        const int pb = 1 + 8 * l;
        unsigned char* wl = ws + WS_W + (size_t)l * W_LAYER;
        const bf16* Win_t = (const bf16*)(wl + WO_IN); const bf16* Wout_t = (const bf16*)(wl + WO_OUT); const bf16* Wgu_t = (const bf16*)(wl + WO_GU); const bf16* Wd_t = (const bf16*)(wl + WO_D);
        const float* xprev = (l == 0) ? x_in : xres;

        if (IN(pb + 0)) { asm volatile("" : "+s"(ap)); int tid = threadIdx.x; asm volatile("" : "+v"(tid)); const int lane = tid & 63, wave = __builtin_amdgcn_readfirstlane(tid >> 6), gw = blockIdx.x * NWAVES + wave, gt = blockIdx.x * NTHR + tid; (void)lane; (void)gw; (void)gt;
            pg8::Gemm g{XN, Win_t, M, LDP, DM}; pg8::StaticOrder S; S.init(M, LDP, G, (int)blockIdx.x);
            pg8::EpiBf16<0> E{PROJ, LDP, nullptr, 0, 0, 1.f};
            pg8::gemm_phase<pg8::EpiBf16<0>, pg8::StaticOrder, true, true>(ldsp, g, S, E);
            if (IN(pb + 0 + 1)) { xcd_barrier(bar); }
        }
        if (IN(pb + 1)) { asm volatile("" : "+s"(ap)); int tid = threadIdx.x; asm volatile("" : "+v"(tid)); const int lane = tid & 63, wave = __builtin_amdgcn_readfirstlane(tid >> 6), gw = blockIdx.x * NWAVES + wave, gt = blockIdx.x * NTHR + tid; (void)lane; (void)gw; (void)gt;
            if (flags & 1) for (int u = blockIdx.x; u < BATCH * 16; u += G) kmean_unit(ldsp, u >> 4, u & 15, PROJ, KMEAN, tid, wave, lane);
            if (flags & 2) { const bf16* WaT = (const bf16*)(ws + WS_LRUW) + (size_t)l * 32768; const bf16* WxT = WaT + 16384;
                for (int u = blockIdx.x; u < BATCH * 32; u += G) lru_pass(ldsp, u >> 5, u & 31, PROJ, WaT, WxT, ap->in[7] + (size_t)l * 1024, ap->in[8] + (size_t)l * 256,
                    ap->in[10] + (size_t)l * 256, ap->in[12] + (size_t)l * 256, ap->in[13] + (size_t)l * 256, LRUSUM, (bf16*)Y, (bf16*)Y + (size_t)M * 256, tid, wave, lane); }
            if (flags & 4) for (int u = blockIdx.x; u < BATCH * 32; u += G) gla_unit<false>(ldsp, u >> 5, (u >> 3) & 3, u & 7, PROJ, ap->in[15] + (size_t)l * 128, ap->in[16] + (size_t)l * 256, GLASUM, MIX, tid, wave, lane);
            if (IN(pb + 1 + 1)) { xcd_barrier(bar); }
        }
        if (IN(pb + 2)) { asm volatile("" : "+s"(ap)); int tid = threadIdx.x; asm volatile("" : "+v"(tid)); const int lane = tid & 63, wave = __builtin_amdgcn_readfirstlane(tid >> 6), gw = blockIdx.x * NWAVES + wave, gt = blockIdx.x * NTHR + tid; (void)lane; (void)gw; (void)gt;
            if (flags & 2) for (int u = blockIdx.x; u < BATCH * 32; u += G) lru_final(ldsp, u >> 5, u & 31, PROJ, LRUSUM, (const bf16*)Y, (const bf16*)Y + (size_t)M * 256, MIX, tid);
            if (flags & 4) for (int u = blockIdx.x; u < BATCH * 32; u += G) gla_unit<true>(ldsp, u >> 5, (u >> 3) & 3, u & 7, PROJ, ap->in[15] + (size_t)l * 128, ap->in[16] + (size_t)l * 256, GLASUM, MIX, tid, wave, lane);
            if ((flags & 8) && G == 256) {
                const attn_body::AttnTensors AT{(const attn_body::bf16*)(PROJ + C_MQ), (const attn_body::bf16*)(PROJ + C_MK), (const attn_body::bf16*)(PROJ + C_MV), (attn_body::bf16*)(MIX + 512), KMEAN, BIAST};
                const attn_body::StaticOrder S((int)G, (int)blockIdx.x);
                attn_body::attn_phase<attn_body::StaticOrder>((char*)lds, AT, S);
            }
            if (IN(pb + 2 + 1)) { xcd_barrier(bar); }
        }
        if (IN(pb + 3)) { asm volatile("" : "+s"(ap)); int tid = threadIdx.x; asm volatile("" : "+v"(tid)); const int lane = tid & 63, wave = __builtin_amdgcn_readfirstlane(tid >> 6), gw = blockIdx.x * NWAVES + wave, gt = blockIdx.x * NTHR + tid; (void)lane; (void)gw; (void)gt;
            pg8::Gemm g{MIX, Wout_t, M, DM, DM}; pg8::StaticOrder S; S.init(M, DM, G, (int)blockIdx.x);
            pg8::EpiF32 E{Y, DM, nullptr};
            pg8::gemm_phase<pg8::EpiF32, pg8::StaticOrder, true, true>(ldsp, g, S, E);
            if (IN(pb + 3 + 1)) { xcd_barrier(bar); }
        }
        if (IN(pb + 4)) { asm volatile("" : "+s"(ap)); int tid = threadIdx.x; asm volatile("" : "+v"(tid)); const int lane = tid & 63, wave = __builtin_amdgcn_readfirstlane(tid >> 6), gw = blockIdx.x * NWAVES + wave, gt = blockIdx.x * NTHR + tid; (void)lane; (void)gw; (void)gt;
            const float* gpost = ap->in[2] + (size_t)l * DM; const float* gnext = ap->in[3] + (size_t)l * DM;
            for (int m = gw; m < M; m += NGW) resnorm_row(Y + (size_t)m * DM, xprev + (size_t)m * DM, gpost, xres + (size_t)m * DM, gnext, XN + (size_t)m * DM, lane);
            if (IN(pb + 4 + 1)) { xcd_barrier(bar); }
        }
        if (IN(pb + 5)) { asm volatile("" : "+s"(ap)); int tid = threadIdx.x; asm volatile("" : "+v"(tid)); const int lane = tid & 63, wave = __builtin_amdgcn_readfirstlane(tid >> 6), gw = blockIdx.x * NWAVES + wave, gt = blockIdx.x * NTHR + tid; (void)lane; (void)gw; (void)gt;
            pg8::Gemm g{XN, Wgu_t, M, NGU, DM}; pg8::StaticOrder S; S.init(M, NGU, G, (int)blockIdx.x);
            pg8::EpiSwiGLU E{HFF, DFF};
            pg8::gemm_phase<pg8::EpiSwiGLU, pg8::StaticOrder, true, true>(ldsp, g, S, E);
            if (IN(pb + 5 + 1)) { xcd_barrier(bar); }
        }
        if (IN(pb + 6)) { asm volatile("" : "+s"(ap)); int tid = threadIdx.x; asm volatile("" : "+v"(tid)); const int lane = tid & 63, wave = __builtin_amdgcn_readfirstlane(tid >> 6), gw = blockIdx.x * NWAVES + wave, gt = blockIdx.x * NTHR + tid; (void)lane; (void)gw; (void)gt;
            pg8::Gemm g{HFF, Wd_t, M, DM, DFF}; pg8::StaticOrder S; S.init(M, DM, G, (int)blockIdx.x);
            pg8::EpiF32 E{Y, DM, nullptr};
            pg8::gemm_phase<pg8::EpiF32, pg8::StaticOrder, true, true>(ldsp, g, S, E);
            if (IN(pb + 6 + 1)) { xcd_barrier(bar); }
        }
        if (IN(pb + 7)) { asm volatile("" : "+s"(ap)); int tid = threadIdx.x; asm volatile("" : "+v"(tid)); const int lane = tid & 63, wave = __builtin_amdgcn_readfirstlane(tid >> 6), gw = blockIdx.x * NWAVES + wave, gt = blockIdx.x * NTHR + tid; (void)lane; (void)gw; (void)gt;
            const float* gpost = ap->in[4] + (size_t)l * DM; const float* gnext = (l + 1 < NLAYER) ? ap->in[1] + (size_t)(l + 1) * DM : nullptr;
            for (int m = gw; m < M; m += NGW) resnorm_row(Y + (size_t)m * DM, xres + (size_t)m * DM, gpost, xres + (size_t)m * DM, gnext, XN + (size_t)m * DM, lane);
            if (IN(pb + 7 + 1)) { xcd_barrier(bar); }
        }
}
#undef IN

__global__ void __launch_bounds__(NTHR, 2) mk_fwd(Args args) {
    extern __shared__ __attribute__((aligned(16))) unsigned char lds[];
    LAS unsigned char* ldsp = (LAS unsigned char*)lds;
    const int tid = threadIdx.x, lane = tid & 63, wave = __builtin_amdgcn_readfirstlane(tid >> 6);
    const int G = gridDim.x, gw = blockIdx.x * NWAVES + wave, NGW = G * NWAVES, gt = blockIdx.x * NTHR + tid, NGT = G * NTHR;
    unsigned char* ws = args.ws;
    const int lo = args.ph_lo, hi = args.ph_hi;
#define IN(k) (lo <= (k) && (k) < hi)
    const float* x_in = args.in[0];
    float* xres = args.out;
    bf16* XN = (bf16*)(ws + WS_XN); bf16* PROJ = (bf16*)(ws + WS_PROJ); bf16* HFF = (bf16*)(ws + WS_PROJ); bf16* MIX = (bf16*)(ws + WS_MIX); float* Y = (float*)(ws + WS_Y);
    float* KMEAN = (float*)(ws + WS_KMEAN); float* BIAST = (float*)(ws + WS_BIAS); float* LRUSUM = (float*)(ws + WS_LRUSUM); float* GLASUM = (float*)(ws + WS_GLASUM);
    for (int u = tid; u < (LDS_BYTES - LDSCTL_OFF) / 4; u += NTHR) ((LAS unsigned*)(ldsp + LDSCTL_OFF))[u] = 0u;
    __syncthreads();
    const XcdBarrier bar = xcd_barrier_post((unsigned*)(ws + WS_CTL) + CW_BAR + args.pad * XCD_BAR_WORDS, (volatile LAS unsigned*)(ldsp + MISC_OFF) + 8);

    if (IN(0)) {
        LAS float* scr = (LAS float*)(ldsp + wave * 16384);
        for (int l = 0; l < NLAYER; ++l) {
            unsigned char* wl = ws + WS_W + (size_t)l * W_LAYER;
            bf16* Win_t = (bf16*)(wl + WO_IN); bf16* Wout_t = (bf16*)(wl + WO_OUT); bf16* Wgu_t = (bf16*)(wl + WO_GU); bf16* Wd_t = (bf16*)(wl + WO_D);
            const float* w_in = args.in[5] + (size_t)l * DM * D_IN; const float* w_out = args.in[6] + (size_t)l * DM * DM;
            const float* w2 = args.in[14] + (size_t)l * 16 * 128;
            const float* wg = args.in[18] + (size_t)l * DM * DFF; const float* wu = args.in[19] + (size_t)l * DM * DFF; const float* wd = args.in[20] + (size_t)l * DFF * DM;
            constexpr int KB = DM / 64;
            constexpr int I_IN = (LDP / 32) * KB, I_OUT = (DM / 32) * KB, I_GU = (NGU / 32) * KB, I_D = (DM / 32) * (DFF / 64);
            for (int it = gw; it < I_IN + I_OUT + I_GU + I_D; it += NGW) {
                int r = it;
                if (r < I_IN) { const int nb = r / KB, kb = r % KB, n0 = nb * 32;
                    if (n0 < 2816) { const int s0 = n0 < 1024 ? n0 : n0 + 16; const float sc = (n0 >= C_GQ && n0 < C_GK) ? GLA_QS : ((n0 >= C_MQ && n0 < C_MK) ? MOBA_C2 : 1.0f);
                        tr_item(w_in, D_IN, s0, DM, Win_t, n0, kb * 64, sc, scr, lane); }
                    else if (n0 < 2944) trz_item(w_in, w2, Win_t, n0, n0 - 2816, kb * 64, scr, lane);
                    else { const int c = lane & 7;
#pragma unroll
                        for (int j = 0; j < 4; ++j) { const int n = (lane >> 3) + 8 * j; *(GAS v4u*)(Win_t + (size_t)(n0 + n) * DM + kb * 64 + 8 * c) = (v4u){0u, 0u, 0u, 0u}; } }
                    continue; }
                r -= I_IN;
                if (r < I_OUT) { const int nb = r / KB, kb = r % KB; tr_item(w_out, DM, nb * 32, DM, Wout_t, nb * 32, kb * 64, 1.0f, scr, lane); continue; }
                r -= I_OUT;
                if (r < I_GU) { const int nb = r / KB, kb = r % KB, n0 = nb * 32, pn = n0 >> 8, within = n0 & 255;
                    if (within < 128) tr_item(wg, DFF, pn * 128 + within, DM, Wgu_t, n0, kb * 64, 1.0f, scr, lane);
                    else tr_item(wu, DFF, pn * 128 + within - 128, DM, Wgu_t, n0, kb * 64, 1.0f, scr, lane);
                    continue; }
                r -= I_GU;
                { constexpr int KBD = DFF / 64; const int nb = r / KBD, kb = r % KBD; tr_item(wd, DM, nb * 32, DFF, Wd_t, nb * 32, kb * 64, 1.0f, scr, lane); }
            }
        }
        for (int i = gt; i < NLAYER * 2 * 16384; i += NGT) { const int l = i >> 15, which = (i >> 14) & 1, g = (i >> 12) & 3, j = (i >> 6) & 63, k = i & 63;
            ((bf16*)(ws + WS_LRUW))[i] = (bf16)f2bf(args.in[which ? 11 : 9][(size_t)l * 16384 + (g * 64 + k) * 64 + j]); }
        for (int i = gt; i < 8 * 132; i += NGT) { const int h = i / 132, d = i % 132; BIAST[i] = args.in[17][t5_bucket(d < 128 ? d : 128) * 8 + h] * LOG2E; }
        for (int m = gw; m < M; m += NGW) norm_row(x_in + (size_t)m * DM, args.in[1], XN + (size_t)m * DM, lane);
        if (IN(1)) { xcd_barrier(bar); }
    }

    { Ctx C{(CArgs*)__builtin_amdgcn_kernarg_segment_ptr(), bar, ldsp, lds}; layer_body<0>(C); layer_body<1>(C); }
#undef IN
}

extern "C" void kernel_launch(void* const* d_in, const int* in_sizes, int n_in, void* d_out, int out_size, void* d_ws, size_t ws_size, hipStream_t stream) {
    static int grid = 0;
    if (grid == 0) {
        if (n_in != 21 || in_sizes[0] != M * DM || out_size != M * DM || ws_size < WS_END) { fprintf(stderr, "kernel_launch: unexpected shapes (n_in %d in0 %d out %d ws %zu)\n", n_in, n_in > 0 ? in_sizes[0] : -1, out_size, ws_size); grid = -1; return; }
        if (hipFuncSetAttribute((const void*)mk_fwd, hipFuncAttributeMaxDynamicSharedMemorySize, LDS_BYTES) != hipSuccess) { fprintf(stderr, "kernel_launch: hipFuncSetAttribute failed\n"); grid = -1; return; }
        int dev = 0, cus = 0;
        if (hipGetDevice(&dev) != hipSuccess || hipDeviceGetAttribute(&cus, hipDeviceAttributeMultiprocessorCount, dev) != hipSuccess) { grid = -1; return; }
        (void)hipGetLastError();
        grid = cus;
    }
    if (grid < 0) return;
    (void)hipMemsetAsync((char*)d_ws + WS_CTL, 0, CTL_ZERO_BYTES, stream);
    Args a{};
    for (int i = 0; i < 21; ++i) a.in[i] = (const float*)d_in[i];
    a.out = (float*)d_out; a.ws = (unsigned char*)d_ws;
    constexpr int FAST = FAST_FLAGS;
    a.flags = FAST; a.pad = 0;
    const int nf = (~FAST) & 15;
#ifdef PROBE_DUP
    a.ph_lo = 0; a.ph_hi = PROBE_DUP + 1; a.pad = 0; hipLaunchKernelGGL(mk_fwd, dim3(grid), dim3(NTHR), LDS_BYTES, stream, a);
    a.ph_lo = PROBE_DUP; a.ph_hi = 17; a.pad = 1; hipLaunchKernelGGL(mk_fwd, dim3(grid), dim3(NTHR), LDS_BYTES, stream, a); return;
#endif
    if (nf == 0) { a.ph_lo = 0; a.ph_hi = 17; hipLaunchKernelGGL(mk_fwd, dim3(grid), dim3(NTHR), LDS_BYTES, stream, a); return; }
    for (int p = 0; p < 17; ++p) {
        const int r = (p - 1) % 8, l = (p - 1) / 8;
        if (p >= 1 && r == 1 && (nf & 7)) { hipLaunchKernelGGL(naive_a1, dim3(2048), dim3(256), 0, stream, a, l, nf); if (nf & 2) hipLaunchKernelGGL(naive_a2, dim3(2048), dim3(256), 0, stream, a, l); }
        if (p >= 1 && r == 2) { if (nf & 6) hipLaunchKernelGGL(naive_c1, dim3(2048), dim3(256), 0, stream, a, l, nf); if (nf & 8) hipLaunchKernelGGL(naive_c2, dim3(2048), dim3(256), 0, stream, a, l); }
        a.ph_lo = p; a.ph_hi = p + 1; hipLaunchKernelGGL(mk_fwd, dim3(grid), dim3(NTHR), LDS_BYTES, stream, a); }
}
```
